# Optimizing an MI355X kernel written in HIP

```python
import jax, jax.numpy as jnp
from jax import lax
import numpy as np

D_MODEL = 1024
BATCH = 16
SEQ = 4096
DEPTH = 2
DEC_BATCH = 8
DEC_SEQ = 4096
PAST_LEN = 128

A_HEADS = 8
A_HEAD_DIM = 64
A_WIDTH = A_HEADS * A_HEAD_DIM
DECAY_LORA = 64
ICLR_LORA = 64
GATE_LORA = 160
GN_EPS = 64e-5
B_HEADS = 8
Q_RANK = 256
KV_RANK = 128
QK_NOPE = 64
QK_ROPE = 32
V_DIM = 64
B_WIDTH = B_HEADS * V_DIM
ROPE_THETA = 10000.0
Q_BLOCK = 128
D_FF = ((8 * D_MODEL // 3 + 255) // 256) * 256
RMS_EPS = 1e-6

SHIFT_WIDTH = 3 * A_WIDTH + 2 * DECAY_LORA + 2 * ICLR_LORA + GATE_LORA
IN_SPLITS = (2 * D_MODEL, SHIFT_WIDTH, Q_RANK, KV_RANK, QK_ROPE)
N_IN = sum(IN_SPLITS)
A_SPLITS = (A_WIDTH, A_WIDTH, A_WIDTH, DECAY_LORA, DECAY_LORA, ICLR_LORA, ICLR_LORA, GATE_LORA)

kernel_name = "hybrid_rwkv7_mla_gated_encoder"


def _split(t, sizes):
    offs = []
    acc = 0
    for s in sizes[:-1]:
        acc += s
        offs.append(acc)
    return jnp.split(t, offs, axis=-1)


def _rmsnorm(x, g):
    x32 = x.astype(jnp.float32)
    y = x32 * lax.rsqrt(jnp.mean(x32 * x32, axis=-1, keepdims=True) + RMS_EPS)
    return (y * g.astype(jnp.float32)).astype(x.dtype)


def _token_shift(p, mu):
    p_prev = jnp.pad(p[:, :-1], ((0, 0), (1, 0), (0, 0)))
    p_next = jnp.pad(p[:, 1:], ((0, 0), (0, 1), (0, 0)))
    return p + mu[0] * (p_prev - p) + mu[1] * (p_next - p)


def _rope_tables(s):
    pos = jnp.arange(s, dtype=jnp.float32)
    inv_freq = 1.0 / (ROPE_THETA ** (jnp.arange(0, QK_ROPE, 2, dtype=jnp.float32) / QK_ROPE))
    ang = pos[:, None] * inv_freq[None, :]
    ang = jnp.concatenate([ang, ang], axis=-1)
    return jnp.cos(ang), jnp.sin(ang)


def _rope(x, cos, sin):
    x1, x2 = jnp.split(x, 2, axis=-1)
    rot = jnp.concatenate([-x2, x1], axis=-1)
    return x * cos.astype(x.dtype) + rot * sin.astype(x.dtype)


def _rwkv7_scan(r, w, k, v, kk, a, reverse):
    bsz, _, h, n = r.shape

    def step(state, inp):
        r_t, w_t, k_t, v_t, kk_t, a_t = inp
        sa = jnp.einsum('bhvk,bhk->bhv', state, kk_t)
        state = (state * w_t[:, :, None, :]
                 - sa[..., None] * (kk_t * a_t)[:, :, None, :]
                 + v_t[..., None] * k_t[:, :, None, :])
        return state, jnp.einsum('bhvk,bhk->bhv', state, r_t)

    xs = tuple(jnp.swapaxes(t, 0, 1) for t in (r, w, k, v, kk, a))
    s0 = jnp.zeros((bsz, h, n, n), jnp.float32)
    _, o = lax.scan(step, s0, xs, reverse=reverse)
    return jnp.swapaxes(o, 0, 1)


def _rwkv7_branch(p, w2, w0, a2, a0, g2, k_k, k_a, r_k, gn_g, gn_b):
    bsz, s, _ = p.shape
    pr, pk, pv, pwf, pwb, paf, pab, pg = _split(p.astype(jnp.float32), A_SPLITS)

    def heads(t):
        return t.reshape(bsz, s, A_HEADS, A_HEAD_DIM)

    def decay(lora, up, base):
        wl = -jax.nn.softplus(-(base + jnp.tanh(lora) @ up)) - 0.5
        return jnp.exp(-jnp.exp(wl))

    def iclr(lora, up, base):
        return jax.nn.sigmoid(base + lora @ up)

    wf, wb = decay(pwf, w2[0], w0[0]), decay(pwb, w2[1], w0[1])
    af, ab = iclr(paf, a2[0], a0[0]), iclr(pab, a2[1], a0[1])
    g = jax.nn.sigmoid(pg) @ g2
    kk = heads(pk * k_k)
    kk = kk / jnp.maximum(jnp.sqrt(jnp.sum(kk * kk, axis=-1, keepdims=True)), 1e-12)
    kf = pk * (1.0 + (af - 1.0) * k_a)
    kb = pk * (1.0 + (ab - 1.0) * k_a)
    r, v = heads(pr), heads(pv)
    o = (_rwkv7_scan(r, heads(wf), heads(kf), v, kk, heads(af), reverse=False)
         + _rwkv7_scan(r, heads(wb), heads(kb), v, kk, heads(ab), reverse=True))
    mean = jnp.mean(o, axis=-1, keepdims=True)
    var = jnp.mean(jnp.square(o - mean), axis=-1, keepdims=True)
    o = ((o - mean) * lax.rsqrt(var + GN_EPS)).reshape(bsz, s, A_WIDTH) * gn_g + gn_b
    bonus = jnp.sum(r * heads(pk) * r_k, axis=-1, keepdims=True) * v
    return (o + bonus.reshape(bsz, s, A_WIDTH)) * g


def _mla_branch(pq, pkv, pkr, q_norm_g, w_uq, kv_norm_g, w_ukv, cos, sin):
    bsz, s, _ = pq.shape
    q = (_rmsnorm(pq, q_norm_g) @ w_uq).reshape(bsz, s, B_HEADS, QK_NOPE + QK_ROPE)
    q_nope = q[..., :QK_NOPE]
    q_rope = _rope(q[..., QK_NOPE:], cos[:, None, :], sin[:, None, :])
    kv = (_rmsnorm(pkv, kv_norm_g) @ w_ukv).reshape(bsz, s, B_HEADS, QK_NOPE + V_DIM)
    k_nope, v = kv[..., :QK_NOPE], kv[..., QK_NOPE:]
    k_rope = _rope(pkr, cos, sin)
    scale = (QK_NOPE + QK_ROPE) ** -0.5
    nb = s // Q_BLOCK

    def blk(qs):
        qn, qr = qs
        sc = (jnp.einsum('bqhd,bkhd->bhqk', qn, k_nope)
              + jnp.einsum('bqhd,bkd->bhqk', qr, k_rope))
        prob = jax.nn.softmax(sc.astype(jnp.float32) * scale, axis=-1)
        return jnp.einsum('bhqk,bkhd->bqhd', prob.astype(v.dtype), v)

    def qblocks(t):
        return jnp.moveaxis(t.reshape(bsz, nb, Q_BLOCK, B_HEADS, t.shape[-1]), 1, 0)

    o = lax.map(blk, (qblocks(q_nope), qblocks(q_rope)))
    return jnp.moveaxis(o, 0, 1).reshape(bsz, s, B_WIDTH)


def _trunk(x, norm_mix_g, w_in, shift_mu, decay_w2, decay_w0, iclr_a2, iclr_a0, gate_g2,
           k_k, k_a, r_k, gn_g, gn_b, w_oa, q_norm_g, w_uq, kv_norm_g, w_ukv, w_ob,
           w_out, norm_ffn_g, w_gu, w_down, final_norm_g):
    cos, sin = _rope_tables(x.shape[1])
    for l in range(DEPTH):
        h = _rmsnorm(x, norm_mix_g[l])
        gates, p_a, pq, pkv, pkr = _split(h @ w_in[l], IN_SPLITS)
        p_a = _token_shift(p_a, shift_mu[l])
        y_a = _rwkv7_branch(p_a, decay_w2[l], decay_w0[l], iclr_a2[l], iclr_a0[l], gate_g2[l],
                            k_k[l], k_a[l], r_k[l], gn_g[l], gn_b[l]).astype(x.dtype) @ w_oa[l]
        y_b = _mla_branch(pq, pkv, pkr, q_norm_g[l], w_uq[l], kv_norm_g[l], w_ukv[l], cos, sin) @ w_ob[l]
        g_a, g_b = jnp.split(jax.nn.sigmoid(gates), 2, axis=-1)
        x = x + (g_a * y_a + g_b * y_b) @ w_out[l]
        h = _rmsnorm(x, norm_ffn_g[l])
        gt, up = jnp.split(h @ w_gu[l], 2, axis=-1)
        x = x + (jax.nn.silu(gt) * up) @ w_down[l]
    return _rmsnorm(x, final_norm_g)


def setup_inputs(seed: int = 0) -> dict:
    key = jax.random.key(seed)
    ks = jax.random.split(key, 32)
    f32 = jnp.float32

    def nrm(k, shape, scale):
        return jax.random.normal(k, shape, f32) * scale

    return {
        "x_prompt": nrm(ks[0], (BATCH, SEQ, D_MODEL), 1.0),
        "x_sample": nrm(ks[1], (DEC_BATCH, DEC_SEQ, D_MODEL), 1.0),
        "norm_mix_g": 1.0 + nrm(ks[2], (DEPTH, D_MODEL), 0.02),
        "w_in": nrm(ks[3], (DEPTH, D_MODEL, N_IN), D_MODEL ** -0.5),
        "shift_mu": 0.3 + nrm(ks[4], (DEPTH, 2, SHIFT_WIDTH), 0.1),
        "decay_w2": nrm(ks[5], (DEPTH, 2, DECAY_LORA, A_WIDTH), 0.1 * DECAY_LORA ** -0.5),
        "decay_w0": nrm(ks[6], (DEPTH, 2, A_WIDTH), 1.0),
        "iclr_a2": nrm(ks[7], (DEPTH, 2, ICLR_LORA, A_WIDTH), 0.1 * ICLR_LORA ** -0.5),
        "iclr_a0": nrm(ks[8], (DEPTH, 2, A_WIDTH), 0.5),
        "gate_g2": nrm(ks[9], (DEPTH, GATE_LORA, A_WIDTH), GATE_LORA ** -0.5),
        "k_k": 0.85 + nrm(ks[10], (DEPTH, A_WIDTH), 0.05),
        "k_a": 1.0 + nrm(ks[11], (DEPTH, A_WIDTH), 0.05),
        "r_k": nrm(ks[12], (DEPTH, A_HEADS, A_HEAD_DIM), 0.1),
        "gn_g": 1.0 + nrm(ks[13], (DEPTH, A_WIDTH), 0.02),
        "gn_b": nrm(ks[14], (DEPTH, A_WIDTH), 0.02),
        "w_oa": nrm(ks[15], (DEPTH, A_WIDTH, D_MODEL), A_WIDTH ** -0.5),
        "q_norm_g": 1.0 + nrm(ks[16], (DEPTH, Q_RANK), 0.02),
        "w_uq": nrm(ks[17], (DEPTH, Q_RANK, B_HEADS * (QK_NOPE + QK_ROPE)), Q_RANK ** -0.5),
        "kv_norm_g": 1.0 + nrm(ks[18], (DEPTH, KV_RANK), 0.02),
        "w_ukv": nrm(ks[19], (DEPTH, KV_RANK, B_HEADS * (QK_NOPE + V_DIM)), KV_RANK ** -0.5),
        "w_ob": nrm(ks[20], (DEPTH, B_WIDTH, D_MODEL), B_WIDTH ** -0.5),
        "w_out": nrm(ks[21], (DEPTH, D_MODEL, D_MODEL), D_MODEL ** -0.5),
        "norm_ffn_g": 1.0 + nrm(ks[22], (DEPTH, D_MODEL), 0.02),
        "w_gu": nrm(ks[23], (DEPTH, D_MODEL, 2 * D_FF), D_MODEL ** -0.5),
        "w_down": nrm(ks[24], (DEPTH, D_FF, D_MODEL), D_FF ** -0.5),
        "final_norm_g": 1.0 + nrm(ks[25], (D_MODEL,), 0.02),
    }


def reference(x_prompt, x_sample, norm_mix_g, w_in, shift_mu, decay_w2, decay_w0, iclr_a2,
              iclr_a0, gate_g2, k_k, k_a, r_k, gn_g, gn_b, w_oa, q_norm_g, w_uq, kv_norm_g,
              w_ukv, w_ob, w_out, norm_ffn_g, w_gu, w_down, final_norm_g):
    y_prompt = _trunk(x_prompt, norm_mix_g, w_in, shift_mu, decay_w2, decay_w0, iclr_a2, iclr_a0,
                      gate_g2, k_k, k_a, r_k, gn_g, gn_b, w_oa, q_norm_g, w_uq, kv_norm_g, w_ukv,
                      w_ob, w_out, norm_ffn_g, w_gu, w_down, final_norm_g)
    y_sample = _trunk(x_sample, norm_mix_g, w_in, shift_mu, decay_w2, decay_w0, iclr_a2, iclr_a0,
                      gate_g2, k_k, k_a, r_k, gn_g, gn_b, w_oa, q_norm_g, w_uq, kv_norm_g, w_ukv,
                      w_ob, w_out, norm_ffn_g, w_gu, w_down, final_norm_g)
    return (y_prompt, y_sample)
```

```cpp
#include <hip/hip_runtime.h>
#include <hip/hip_cooperative_groups.h>
#include <cstdio>
#include <cstdint>
#include <cmath>
namespace cg = cooperative_groups;
#ifndef MULTI_LAUNCH
#define MULTI_LAUNCH 0
#endif
__device__ __forceinline__ int tid_() { int t = threadIdx.x; asm volatile("" : "+v"(t)); return t; }
__device__ __forceinline__ int bid_() { int b = blockIdx.x; asm volatile("" : "+s"(b)); return b; }
__device__ __forceinline__ int nblk_() { int g = gridDim.x; asm volatile("" : "+s"(g)); return g; }
namespace pg8 {
#define PG8_LAS __attribute__((address_space(3)))
typedef unsigned short bf16_t;
typedef short bf16x8 __attribute__((ext_vector_type(8)));
typedef float f32x4 __attribute__((ext_vector_type(4)));
typedef unsigned u32x4 __attribute__((ext_vector_type(4)));
constexpr int BM = 256, BK = 64, HALF = 128, HTB = HALF * BK * 2  , STAGE_BYTES = 8 * HTB, NXCD = 8, WGM = 8;

__host__ __device__ __forceinline__ int lds_byte(int r, int c) { const int st = (r >> 4) * 2 + (c >> 5), rr = r & 15, cc = c & 31, ob = rr * 64 + cc * 2; return st * 1024 + (ob ^ (((ob >> 9) & 1) << 5)); }
__host__ __device__ __forceinline__ void stage_rc(int b, int& R, int& C) { const int st = b / 1024, sb = b % 1024, swz = sb ^ (((sb >> 9) & 1) << 5); R = (st >> 1) * 16 + swz / 64; C = (st & 1) * 32 + (swz % 64) / 2; }
__host__ __device__ __forceinline__ int perm32(int rho) { const int n = rho >> 4, i = rho & 15; return 8 * (i >> 2) + 4 * n + (i & 3); }

struct Unit { int pm, pn; };
struct Gemm { const bf16_t* A; const bf16_t* Bt; int M, N, K, lda, ldb; };

struct StaticOrder {
    int nM, nN, nwg, G, c;
    __host__ __device__ void init(int M, int N, int G_, int c_) { nM = M / BM; nN = N / BM; nwg = nM * nN; G = G_; c = c_; }
    __host__ __device__ bool next(int i, Unit& u) const {
        const long L = (long)i * G + c; if (L >= nwg) return false;
        int wgid = (int)L; { const int q = nwg / NXCD, r = nwg % NXCD, xcd = wgid % NXCD, off = wgid / NXCD; wgid = (xcd < r ? xcd * (q + 1) : r * (q + 1) + (xcd - r) * q) + off; }
        const int nig = WGM * nN, gid = wgid / nig, fm = gid * WGM, gsz = (nM - fm) < WGM ? (nM - fm) : WGM;
        u.pm = fm + ((wgid % nig) % gsz); u.pn = (wgid % nig) / gsz; return true;
    }
    __device__ __forceinline__ void a_ready(const Unit&) const {}
    __device__ __forceinline__ void done(const Unit&) const {}
};

template <class Epi, class Sched, bool ALIGN_EPI = false, bool SP2 = false>
__device__ __forceinline__ void gemm_phase(PG8_LAS unsigned char* lds, const Gemm g, const Sched& S, const Epi& E) {
    const int tid = tid_(), wid = __builtin_amdgcn_readfirstlane(tid >> 6), lane = tid & 63, wr = wid >> 2, wc = wid & 3, fr = lane & 15, fq = lane >> 4;
    const int K = g.K, nt = K / BK;
    unsigned voffA[2], voffB[2];
#pragma unroll
    for (int i = 0; i < 2; ++i) { int R, C; stage_rc(tid * 16 + i * 8192, R, C); const int Rb = Epi::PERM ? ((R & ~31) + perm32(R & 31)) : R;
        voffA[i] = (unsigned)(R * g.lda + C) * 2u; voffB[i] = (unsigned)(Rb * g.ldb + C) * 2u; }
    const size_t kstep = (size_t)(BK * 2);
    const size_t hsA = (size_t)HALF * g.lda * 2, hsB = (size_t)HALF * g.ldb * 2;
    const size_t tsA = 2 * hsA, tsB = 2 * hsB;
    const unsigned ldsw = (unsigned)wid * 1024u;
    const int aoff = lds_byte(wr * 64 + fr, fq * 8), boff = lds_byte(wc * 32 + fr, fq * 8);
#define PG8_SA(b, h) (((b) * 2 + (h)) * HTB)
#define PG8_SB(b, h) ((4 + (b) * 2 + (h)) * HTB)
#define PG8_STAGE(bufoff, gbase, voff) do { _Pragma("unroll") for (int _i = 0; _i < 2; ++_i) \
        __builtin_amdgcn_global_load_lds((const unsigned*)((const char*)(gbase) + (voff)[_i]), (PG8_LAS unsigned*)(lds + (bufoff) + ldsw + _i * 8192), 16, 0, 0); } while (0)
#define PG8_LDA(dst, b, h) do { _Pragma("unroll") for (int m = 0; m < 4; ++m) _Pragma("unroll") for (int k = 0; k < 2; ++k) dst[m][k] = *(const PG8_LAS bf16x8*)(lds + PG8_SA(b, h) + aoff + m * 2048 + k * 1024); } while (0)
#define PG8_LDB(dst, b, h) do { _Pragma("unroll") for (int n = 0; n < 2; ++n) _Pragma("unroll") for (int k = 0; k < 2; ++k) dst[n][k] = *(const PG8_LAS bf16x8*)(lds + PG8_SB(b, h) + boff + n * 2048 + k * 1024); } while (0)
#define PG8_MMA(ai, bj, At, Bt) do { __builtin_amdgcn_s_setprio(1); _Pragma("unroll") for (int m = 0; m < 4; ++m) _Pragma("unroll") for (int n = 0; n < 2; ++n) _Pragma("unroll") for (int k = 0; k < 2; ++k) \
        acc[ai][bj][m][n] = __builtin_amdgcn_mfma_f32_16x16x32_bf16(Bt[n][k], At[m][k], acc[ai][bj][m][n], 0, 0, 0); __builtin_amdgcn_s_setprio(0); } while (0)
#define PG8_WAIT_V(n) asm volatile("s_waitcnt vmcnt(" #n ")" ::: "memory")
#define PG8_WAIT_L(n) asm volatile("s_waitcnt lgkmcnt(" #n ")" ::: "memory")
#define PG8_BAR __builtin_amdgcn_s_barrier()
#define PG8_SCHED __builtin_amdgcn_sched_barrier(0)
    Unit cur, nxt; int ui = 0;
    if (!S.next(0, cur)) return;
    f32x4 acc[2][2][4][2];
#pragma unroll
    for (int a = 0; a < 2; ++a)
#pragma unroll
        for (int b = 0; b < 2; ++b)
#pragma unroll
            for (int m = 0; m < 4; ++m)
#pragma unroll
                for (int n = 0; n < 2; ++n) acc[a][b][m][n] = (f32x4){0.f, 0.f, 0.f, 0.f};
    bf16x8 At[4][2], B0[2][2], B1[2][2];
    const char* cA = (const char*)g.A + (size_t)cur.pm * tsA; const char* cB = (const char*)g.Bt + (size_t)cur.pn * tsB;
    S.a_ready(cur);
    if constexpr (SP2) {
        PG8_STAGE(PG8_SB(0, 0), cB, voffB); PG8_STAGE(PG8_SB(0, 1), cB + hsB, voffB); PG8_STAGE(PG8_SA(0, 0), cA, voffA); PG8_STAGE(PG8_SA(0, 1), cA + hsA, voffA);
        if (wr == 1) PG8_BAR;
        PG8_WAIT_V(2); PG8_BAR;
        PG8_STAGE(PG8_SB(1, 0), cB + kstep, voffB); PG8_STAGE(PG8_SA(1, 0), cA + kstep, voffA); PG8_STAGE(PG8_SB(1, 1), cB + hsB + kstep, voffB);
        PG8_WAIT_V(6); PG8_BAR;
    } else {
        PG8_STAGE(PG8_SB(0, 0), cB, voffB); PG8_STAGE(PG8_SA(0, 0), cA, voffA); PG8_STAGE(PG8_SB(0, 1), cB + hsB, voffB); PG8_STAGE(PG8_SA(0, 1), cA + hsA, voffA);
        if (wr == 1) PG8_BAR;
        PG8_WAIT_V(4); PG8_BAR;
        PG8_STAGE(PG8_SB(1, 0), cB + kstep, voffB); PG8_STAGE(PG8_SA(1, 0), cA + kstep, voffA); PG8_STAGE(PG8_SB(1, 1), cB + hsB + kstep, voffB);
        PG8_WAIT_V(6); PG8_BAR;
    }
    for (;;) {
        const bool has_next = S.next(ui + 1, nxt);
        const char* nA = has_next ? (const char*)g.A + (size_t)nxt.pm * tsA : cA; const char* nB = has_next ? (const char*)g.Bt + (size_t)nxt.pn * tsB : cB;
        for (int t = 0; t < nt; t += 2) {
            const bool last = (t == nt - 2);
            const char* a1 = cA + (size_t)(t + 1) * kstep;
            const char* a2 = last ? nA : cA + (size_t)(t + 2) * kstep; const char* b2 = last ? nB : cB + (size_t)(t + 2) * kstep;
            const char* a3 = a2 + kstep; const char* b3 = b2 + kstep;
            if (last && has_next) S.a_ready(nxt);
            if constexpr (SP2) {
            PG8_LDB(B0, 0, 0); PG8_LDB(B1, 0, 1); PG8_SCHED; PG8_LDA(At, 0, 0); PG8_STAGE(PG8_SA(1, 1), a1 + hsA, voffA);
            PG8_WAIT_V(8); PG8_WAIT_L(0); PG8_BAR; PG8_MMA(0, 0, At, B0); PG8_MMA(0, 1, At, B1); PG8_BAR; PG8_SCHED;
            PG8_LDA(At, 0, 1); PG8_STAGE(PG8_SB(0, 0), b2, voffB); PG8_STAGE(PG8_SB(0, 1), b2 + hsB, voffB); PG8_STAGE(PG8_SA(0, 0), a2, voffA);
            PG8_WAIT_V(8); PG8_WAIT_L(0); PG8_BAR; PG8_MMA(1, 0, At, B0); PG8_MMA(1, 1, At, B1); PG8_BAR; PG8_SCHED;
            PG8_LDB(B0, 1, 0); PG8_LDB(B1, 1, 1); PG8_SCHED; PG8_LDA(At, 1, 0); PG8_STAGE(PG8_SA(0, 1), a2 + hsA, voffA);
            PG8_WAIT_V(8); PG8_WAIT_L(0); PG8_BAR; PG8_MMA(0, 0, At, B0); PG8_MMA(0, 1, At, B1); PG8_BAR; PG8_SCHED;
            PG8_LDA(At, 1, 1); PG8_STAGE(PG8_SB(1, 0), b3, voffB); PG8_STAGE(PG8_SB(1, 1), b3 + hsB, voffB); PG8_STAGE(PG8_SA(1, 0), a3, voffA);
            PG8_WAIT_V(8); PG8_WAIT_L(0); PG8_BAR; PG8_MMA(1, 0, At, B0); PG8_MMA(1, 1, At, B1); PG8_BAR; PG8_SCHED;
            } else {
            PG8_LDB(B0, 0, 0); PG8_SCHED; PG8_LDA(At, 0, 0); PG8_STAGE(PG8_SA(1, 1), a1 + hsA, voffA);
            PG8_WAIT_L(8); PG8_BAR; PG8_WAIT_L(0); PG8_MMA(0, 0, At, B0); PG8_BAR; PG8_SCHED;
            PG8_LDB(B1, 0, 1); PG8_STAGE(PG8_SB(0, 0), b2, voffB);
            PG8_BAR; PG8_WAIT_L(0); PG8_MMA(0, 1, At, B1); PG8_BAR;
            PG8_LDA(At, 0, 1); PG8_STAGE(PG8_SA(0, 0), a2, voffA);
            PG8_BAR; PG8_WAIT_L(0); PG8_MMA(1, 0, At, B0); PG8_BAR; PG8_SCHED;
            PG8_STAGE(PG8_SB(0, 1), b2 + hsB, voffB);
            PG8_WAIT_V(6); PG8_BAR; PG8_MMA(1, 1, At, B1); PG8_BAR;
            PG8_LDB(B0, 1, 0); PG8_SCHED; PG8_LDA(At, 1, 0); PG8_STAGE(PG8_SA(0, 1), a2 + hsA, voffA);
            PG8_WAIT_L(8); PG8_BAR; PG8_WAIT_L(0); PG8_MMA(0, 0, At, B0); PG8_BAR; PG8_SCHED;
            PG8_LDB(B1, 1, 1); PG8_STAGE(PG8_SB(1, 0), b3, voffB);
            PG8_BAR; PG8_WAIT_L(0); PG8_MMA(0, 1, At, B1); PG8_BAR;
            PG8_LDA(At, 1, 1); PG8_STAGE(PG8_SA(1, 0), a3, voffA);
            PG8_BAR; PG8_WAIT_L(0); PG8_MMA(1, 0, At, B0); PG8_BAR; PG8_SCHED;
            PG8_STAGE(PG8_SB(1, 1), b3 + hsB, voffB);
            PG8_WAIT_V(6); PG8_BAR; PG8_MMA(1, 1, At, B1); PG8_BAR;
            }
        }
        if constexpr (ALIGN_EPI) { if (wr == 0) PG8_BAR; }
        if constexpr (!Epi::AFTER_DRAIN) { E(acc, cur, wr, wc, fr, fq); S.done(cur); }
        if (!has_next) break;
#pragma unroll
        for (int a = 0; a < 2; ++a)
#pragma unroll
            for (int b = 0; b < 2; ++b)
#pragma unroll
                for (int m = 0; m < 4; ++m)
#pragma unroll
                    for (int n = 0; n < 2; ++n) acc[a][b][m][n] = (f32x4){0.f, 0.f, 0.f, 0.f};
        cur = nxt; cA = nA; cB = nB; ++ui;
        if constexpr (ALIGN_EPI) { if (wr == 1) PG8_BAR; }
    }
    PG8_WAIT_V(0);
    if constexpr (!ALIGN_EPI) { if (wr == 0) PG8_BAR; }
    PG8_BAR;
    if constexpr (Epi::AFTER_DRAIN) { E.fused(acc, cur, wr, wc, fr, fq, lds, wid, lane); S.done(cur); }
#undef PG8_SA
#undef PG8_SB
#undef PG8_STAGE
#undef PG8_LDA
#undef PG8_LDB
#undef PG8_MMA
#undef PG8_WAIT_V
#undef PG8_WAIT_L
#undef PG8_BAR
#undef PG8_SCHED
}
}

#define LAS __attribute__((address_space(3)))
typedef unsigned short bf16_t;
typedef _Float16 f16;
typedef _Float16 f16x8 __attribute__((ext_vector_type(8)));
typedef float f32x4 __attribute__((ext_vector_type(4)));
typedef float f32x2 __attribute__((ext_vector_type(2)));
typedef float f32x16 __attribute__((ext_vector_type(16)));
typedef unsigned u32x4 __attribute__((ext_vector_type(4)));
typedef unsigned u32x2 __attribute__((ext_vector_type(2)));
typedef short bf16x8 __attribute__((ext_vector_type(8)));
typedef __bf16 bf16x2_t __attribute__((ext_vector_type(2)));

constexpr int DM = 1024, SEQ = 4096, GSEQ = 8, TG = GSEQ * SEQ, NGROUP = 3, DEPTH = 2;
constexpr int NIN = 4416, NINP = 4608, NP2 = 2560, DFF = 2816, NGU = 5632;
constexpr int NWAVES = 8, NTHR = 512;
constexpr float QSCALE = 0.10206207261596577f * 1.4426950408889634f;
constexpr size_t MiB = 1u << 20;
constexpr size_t WS_ROPE = 0;
constexpr size_t WS_RSTD = 512 * 1024;
constexpr size_t WS_BAR = 768 * 1024;
constexpr size_t WS_BS = 1 * MiB;
constexpr size_t WS_W = 2 * MiB;
constexpr size_t WL_IN = 0, WL_DEC = 9 * MiB, WL_ICL = WL_DEC + 256 * 1024, WL_GATE = WL_ICL + 256 * 1024, WL_UQ = WL_GATE + 256 * 1024,
                 WL_UKV = WL_UQ + 384 * 1024, WL_OA = WL_UKV + 256 * 1024, WL_OB = WL_OA + MiB, WL_OUT = WL_OB + MiB, WL_GU = WL_OUT + 2 * MiB,
                 WL_DOWN = WL_GU + 11 * MiB, WL_SIZE = 31 * MiB;
static_assert(WL_DOWN + 5632 * 1024 <= WL_SIZE, "weights");
constexpr size_t WS_H = 64 * MiB;
constexpr size_t WS_P2 = 128 * MiB;
constexpr size_t WS_GATES = WS_P2 + 160 * MiB;
constexpr size_t WS_SC = WS_GATES + 128 * MiB;
constexpr size_t WS_SCD = WS_SC + 96 * MiB;
constexpr size_t WS_V16 = WS_SC + 320 * MiB;
constexpr size_t WS_LIN = WS_V16 + 32 * MiB;
constexpr size_t WS_G = WS_LIN + 32 * MiB;
constexpr size_t WS_Q = WS_G + 32 * MiB;
constexpr size_t WS_KF = WS_Q + 48 * MiB;
constexpr size_t WS_VT = WS_KF + 48 * MiB;
constexpr size_t WS_OATT = WS_VT + 32 * MiB;
constexpr size_t WS_END = WS_OATT + 32 * MiB;
static_assert(WS_END <= 1024 * MiB, "workspace map exceeds 1 GiB");
constexpr int LDS_BYTES = 136 * 1024;

struct Params { const float* in[26]; float* out; unsigned char* ws; float invf[16]; int ph_lo, ph_hi; };
typedef const __attribute__((address_space(4))) Params CParams;

__device__ __forceinline__ unsigned cvtpk(float lo, float hi) { f32x2 v = {lo, hi}; bf16x2_t b = __builtin_convertvector(v, bf16x2_t); return __builtin_bit_cast(unsigned, b); }
__device__ __forceinline__ float bflo(unsigned u) { return __uint_as_float(u << 16); }
__device__ __forceinline__ float bfhi(unsigned u) { return __uint_as_float(u & 0xffff0000u); }
__device__ __forceinline__ void unpack8(u32x4 w, float* v) { v[0] = bflo(w.x); v[1] = bfhi(w.x); v[2] = bflo(w.y); v[3] = bfhi(w.y); v[4] = bflo(w.z); v[5] = bfhi(w.z); v[6] = bflo(w.w); v[7] = bfhi(w.w); }
__device__ __forceinline__ u32x4 pack8(const float* v) { u32x4 w; w.x = cvtpk(v[0], v[1]); w.y = cvtpk(v[2], v[3]); w.z = cvtpk(v[4], v[5]); w.w = cvtpk(v[6], v[7]); return w; }
__device__ __forceinline__ float sigmoidf_(float x) { return __builtin_amdgcn_rcpf(1.0f + __builtin_amdgcn_exp2f(-1.4426950408889634f * x)); }
#define DPP_F(x, ctrl) __builtin_bit_cast(float, __builtin_amdgcn_update_dpp(0, __builtin_bit_cast(int, (x)), (ctrl), 0xF, 0xF, true))
__device__ __forceinline__ float red8(float x) { x += DPP_F(x, 0xB1); x += DPP_F(x, 0x4E); x += DPP_F(x, 0x141); return x; }
__device__ __forceinline__ float red16(float x) { x = red8(x); x += DPP_F(x, 0x140); return x; }
__device__ __forceinline__ float sum8(float v) { return red8(v); }
__device__ __forceinline__ float wave_sum(float v) { const int t = __builtin_bit_cast(int, red16(v));
    return (__builtin_bit_cast(float, __builtin_amdgcn_readlane(t, 0)) + __builtin_bit_cast(float, __builtin_amdgcn_readlane(t, 16))) + (__builtin_bit_cast(float, __builtin_amdgcn_readlane(t, 32)) + __builtin_bit_cast(float, __builtin_amdgcn_readlane(t, 48))); }

#define EPI_ARGS const pg8::f32x4 (&acc)[2][2][4][2], const pg8::Unit& u, int wr, int wc, int fr, int fq
#define FOR_ROWS for (int ai = 0; ai < 2; ++ai) _Pragma("unroll") for (int m = 0; m < 4; ++m)
struct EpiIn {
    static constexpr bool PERM = true, AFTER_DRAIN = false;
    bf16_t* gates; bf16_t* p2;
    __device__ __forceinline__ void operator()(EPI_ARGS) const {
        const bool isg = u.pn < 8; bf16_t* base = isg ? gates : p2; const int ld = isg ? 2048 : NP2; const int c0 = (isg ? u.pn : u.pn - 8) * 256 + wc * 32 + 8 * fq;
#pragma unroll
        FOR_ROWS { const size_t row = (size_t)u.pm * 256 + ai * 128 + wr * 64 + m * 16 + fr;
#pragma unroll
            for (int bj = 0; bj < 2; ++bj) { float v[8];
#pragma unroll
                for (int i = 0; i < 4; ++i) { v[i] = acc[ai][bj][m][0][i]; v[4 + i] = acc[ai][bj][m][1][i]; }
                if (isg) {
#pragma unroll
                    for (int i = 0; i < 8; ++i) v[i] = sigmoidf_(v[i]); }
                *(u32x4*)(base + row * ld + c0 + bj * 128) = pack8(v); } }
    }
};
struct EpiDecay {
    static constexpr bool PERM = true, AFTER_DRAIN = false;
    f16* sc; const float* w0;
    __device__ __forceinline__ void operator()(EPI_ARGS) const {
        const int dir = u.pn >> 1;
#pragma unroll
        for (int bj = 0; bj < 2; ++bj) { const int c = (u.pn & 1) * 256 + bj * 128 + wc * 32 + 8 * fq; const int head = c >> 6, d = c & 63;
            float b0[8];
#pragma unroll
            for (int i = 0; i < 8; ++i) b0[i] = w0[dir * 512 + c + i];
#pragma unroll
            FOR_ROWS { const size_t row = (size_t)u.pm * 256 + ai * 128 + wr * 64 + m * 16 + fr; f16x8 o;
#pragma unroll
                for (int i = 0; i < 8; ++i) { const float z = b0[i] + acc[ai][bj][m][i >> 2][i & 3]; const float y = -z;
                    const float sp = fmaxf(y, 0.f) + __logf(1.0f + __expf(-fabsf(y))); o[i] = (f16)__expf(-__expf(-sp - 0.5f)); }
                *(f16x8*)(sc + (((size_t)dir * TG + row) * 8 + head) * 192 + d) = o; asm volatile("" ::: "memory"); } }
    }
};
struct EpiIclr {
    static constexpr bool PERM = true, AFTER_DRAIN = false;
    const f16* scs; f16* sc; const float* a0; const float* ka;
    __device__ __forceinline__ void operator()(EPI_ARGS) const {
        const int dir = u.pn >> 1;
#pragma unroll
        for (int bj = 0; bj < 2; ++bj) { const int c = (u.pn & 1) * 256 + bj * 128 + wc * 32 + 8 * fq; const int head = c >> 6, d = c & 63;
            float b0[8], kav[8];
#pragma unroll
            for (int i = 0; i < 8; ++i) { b0[i] = a0[dir * 512 + c + i]; kav[i] = ka[c + i]; }
#pragma unroll
            FOR_ROWS { const size_t row = (size_t)u.pm * 256 + ai * 128 + wr * 64 + m * 16 + fr;
                f16* p = sc + (((size_t)dir * TG + row) * 8 + head) * 192 + d; const f16* ps = scs + ((size_t)row * 8 + head) * 192 + d;
                const f16x8 kr = *(const f16x8*)(ps + 64), kk = *(const f16x8*)(ps + 128); f16x8 ko, bo;
#pragma unroll
                for (int i = 0; i < 8; ++i) { const float a = sigmoidf_(b0[i] + acc[ai][bj][m][i >> 2][i & 3]);
                    ko[i] = (f16)((float)kr[i] * (1.0f + (a - 1.0f) * kav[i])); bo[i] = (f16)(-(float)kk[i] * a); }
                *(f16x8*)(p + 64) = ko; *(f16x8*)(p + 128) = bo; asm volatile("" ::: "memory"); } }
    }
};
struct EpiPlain {
    static constexpr bool PERM = true, AFTER_DRAIN = false;
    bf16_t* O; int ld;
    __device__ __forceinline__ void operator()(EPI_ARGS) const {
        const int c0 = u.pn * 256 + wc * 32 + 8 * fq;
#pragma unroll
        FOR_ROWS { const size_t row = (size_t)u.pm * 256 + ai * 128 + wr * 64 + m * 16 + fr;
#pragma unroll
            for (int bj = 0; bj < 2; ++bj) { float v[8];
#pragma unroll
                for (int i = 0; i < 4; ++i) { v[i] = acc[ai][bj][m][0][i]; v[4 + i] = acc[ai][bj][m][1][i]; }
                *(u32x4*)(O + row * ld + c0 + bj * 128) = pack8(v); } }
    }
};
struct EpiQ {
    static constexpr bool PERM = false, AFTER_DRAIN = false;
    bf16_t* Q; const float* rstd; const float* cs; const float* sn;
    __device__ __forceinline__ void operator()(EPI_ARGS) const {
#pragma unroll
        FOR_ROWS { const int row = u.pm * 256 + ai * 128 + wr * 64 + m * 16 + fr; const float rs = rstd[row] * QSCALE; const int t = row & (SEQ - 1);
            const f32x4 c4 = *(const f32x4*)(cs + t * 16 + 4 * fq), s4 = *(const f32x4*)(sn + t * 16 + 4 * fq);
#pragma unroll
            for (int bj = 0; bj < 2; ++bj) { const int cb = u.pn * 256 + bj * 128 + wc * 32; const bool rope = ((cb >> 5) % 3) == 2;
                pg8::f32x4 x1 = acc[ai][bj][m][0] * rs, x2 = acc[ai][bj][m][1] * rs;
                if (rope) { const pg8::f32x4 y1 = x1 * c4 - x2 * s4, y2 = x2 * c4 + x1 * s4; x1 = y1; x2 = y2; }
                u32x2 w1, w2; w1.x = cvtpk(x1[0], x1[1]); w1.y = cvtpk(x1[2], x1[3]); w2.x = cvtpk(x2[0], x2[1]); w2.y = cvtpk(x2[2], x2[3]);
                *(u32x2*)(Q + (size_t)row * 768 + cb + 4 * fq) = w1; *(u32x2*)(Q + (size_t)row * 768 + cb + 16 + 4 * fq) = w2; } asm volatile("" ::: "memory"); }
    }
};
struct EpiKV {
    static constexpr bool PERM = true, AFTER_DRAIN = false;
    bf16_t* KF; bf16_t* VT; const float* rstd;
    __device__ __forceinline__ void operator()(EPI_ARGS) const {
#pragma unroll
        FOR_ROWS { const int row = u.pm * 256 + ai * 128 + wr * 64 + m * 16 + fr; const float rs = rstd[row]; const int s = row >> 12, t = row & (SEQ - 1);
#pragma unroll
            for (int bj = 0; bj < 2; ++bj) { const int c = u.pn * 256 + bj * 128 + wc * 32 + 8 * fq; const int head = c >> 7, w = c & 127; float v[8];
#pragma unroll
                for (int i = 0; i < 4; ++i) { v[i] = acc[ai][bj][m][0][i] * rs; v[4 + i] = acc[ai][bj][m][1][i] * rs; }
                if (w < 64) *(u32x4*)(KF + (size_t)row * 768 + head * 96 + w) = pack8(v);
                else { const u32x4 pk = pack8(v); bf16_t* vp = VT + ((size_t)(s * 8 + head) * 64 + (w - 64)) * SEQ + t;
                    vp[0] = (bf16_t)pk.x; vp[SEQ] = (bf16_t)(pk.x >> 16); vp[2 * SEQ] = (bf16_t)pk.y; vp[3 * SEQ] = (bf16_t)(pk.y >> 16);
                    vp[4 * SEQ] = (bf16_t)pk.z; vp[5 * SEQ] = (bf16_t)(pk.z >> 16); vp[6 * SEQ] = (bf16_t)pk.w; vp[7 * SEQ] = (bf16_t)(pk.w >> 16); } } asm volatile("" ::: "memory"); }
    }
};
template <int SECOND> struct EpiMix {
    static constexpr bool PERM = true, AFTER_DRAIN = false;
    bf16_t* mix; const bf16_t* gates;
    __device__ __forceinline__ void operator()(EPI_ARGS) const {
        const int c0 = u.pn * 256 + wc * 32 + 8 * fq;
#pragma unroll
        FOR_ROWS { const size_t row = (size_t)u.pm * 256 + ai * 128 + wr * 64 + m * 16 + fr;
#pragma unroll
            for (int bj = 0; bj < 2; ++bj) { float v[8], g[8];
                unpack8(*(const u32x4*)(gates + row * 2048 + SECOND * 1024 + c0 + bj * 128), g);
#pragma unroll
                for (int i = 0; i < 4; ++i) { v[i] = acc[ai][bj][m][0][i] * g[i]; v[4 + i] = acc[ai][bj][m][1][i] * g[4 + i]; }
                u32x4* dst = (u32x4*)(mix + row * 1024 + c0 + bj * 128);
                if (SECOND) { float o[8]; unpack8(*dst, o);
#pragma unroll
                    for (int i = 0; i < 8; ++i) v[i] += o[i]; }
                *dst = pack8(v); asm volatile("" ::: "memory"); } }
    }
};
struct EpiRes {
    static constexpr bool PERM = false, AFTER_DRAIN = false;
    const float* src; float* dst;
    __device__ __forceinline__ void operator()(EPI_ARGS) const {
        const int c0 = u.pn * 256 + wc * 32 + 4 * fq;
#pragma unroll
        FOR_ROWS { const size_t off = ((size_t)u.pm * 256 + ai * 128 + wr * 64 + m * 16 + fr) * 1024 + c0;
#pragma unroll
            for (int bj = 0; bj < 2; ++bj)
#pragma unroll
                for (int n = 0; n < 2; ++n) { const pg8::f32x4 b = *(const pg8::f32x4*)(src + off + bj * 128 + n * 16); *(pg8::f32x4*)(dst + off + bj * 128 + n * 16) = b + acc[ai][bj][m][n]; } asm volatile("" ::: "memory"); }
    }
};
struct EpiGU {
    static constexpr bool PERM = false, AFTER_DRAIN = false;
    bf16_t* hid;
    __device__ __forceinline__ void operator()(EPI_ARGS) const {
#pragma unroll
        FOR_ROWS { const size_t row = (size_t)u.pm * 256 + ai * 128 + wr * 64 + m * 16 + fr;
#pragma unroll
            for (int bj = 0; bj < 2; ++bj) { const int grp = (u.pn * 256 + bj * 128 + wc * 32) >> 5; const pg8::f32x4 g = acc[ai][bj][m][0], up = acc[ai][bj][m][1]; float o[4];
#pragma unroll
                for (int i = 0; i < 4; ++i) o[i] = g[i] * sigmoidf_(g[i]) * up[i];
                u32x2 w; w.x = cvtpk(o[0], o[1]); w.y = cvtpk(o[2], o[3]); *(u32x2*)(hid + row * DFF + grp * 16 + 4 * fq) = w; } }
    }
};
#define XB_TMO      128
#define XB_XCNT(j)  (256  + 64 * (j))
#define XB_XSUB(j)  (1280 + 64 * (j))
#define XB_XGEN(j)  (2304 + 64 * (j))
#define XB_TOP      3328
#define XB_TOPGEN   3392
#define XCD_BAR_WORDS 3456
#define XB_SPIN_CAP (1u << 18)

__device__ __forceinline__ unsigned xb_ld(unsigned* p)              { return __hip_atomic_load(p, __ATOMIC_RELAXED, __HIP_MEMORY_SCOPE_AGENT); }
__device__ __forceinline__ unsigned xb_add(unsigned* p, unsigned v) { return __hip_atomic_fetch_add(p, v, __ATOMIC_RELAXED, __HIP_MEMORY_SCOPE_AGENT); }
__device__ __forceinline__ unsigned xb_xcc_id() { return (unsigned)__builtin_amdgcn_s_getreg((3 << 11) | 20) & 0xFu; }
#define XB_SPIN(cond, bar) do { unsigned _sp = 0; while (cond) { __builtin_amdgcn_s_sleep(1); \
    if ((++_sp & 255u) == 0u) { if (xb_ld(&(bar)[XB_TMO])) break; if (_sp > XB_SPIN_CAP) { atomicAdd(&(bar)[XB_TMO], 1u); break; } } } } while (0)

struct XcdBarrier {
    unsigned* bar; unsigned x;
    volatile LAS unsigned* st;
};

__device__ __forceinline__ XcdBarrier xcd_barrier_post(unsigned* bar, volatile LAS unsigned* st) {
    XcdBarrier b; b.bar = bar; b.x = xb_xcc_id(); b.st = st;
    if (threadIdx.x == 0) (void)xb_add(&bar[XB_XCNT(b.x)], 1u);
    return b;
}
__device__ __forceinline__ void xcd_barrier_complete(unsigned* bar, unsigned x, unsigned& nloc, unsigned& nx) {
    const unsigned G = gridDim.x * gridDim.y * gridDim.z;
    unsigned sum, cnt, mine, sp = 0u;
    for (;;) {
        sum = 0u; cnt = 0u; mine = 0u;
#pragma unroll
        for (unsigned j = 0; j < 16; ++j) { const unsigned c = xb_ld(&bar[XB_XCNT(j)]); sum += c; cnt += (c > 0u) ? 1u : 0u; mine = (j == x) ? c : mine; }
        if (sum == G) break;
        __builtin_amdgcn_s_sleep(1);
        if ((++sp & 255u) == 0u) { if (xb_ld(&bar[XB_TMO])) break; if (sp > XB_SPIN_CAP) { atomicAdd(&bar[XB_TMO], 1u); break; } }
    }
    nloc = mine > 0u ? mine : 1u; nx = cnt > 0u ? cnt : 1u;
}

__device__ __forceinline__ void xcd_barrier(const XcdBarrier& b) {
    asm volatile("s_waitcnt vmcnt(0)" ::: "memory");
    __syncthreads();
    if (threadIdx.x == 0) {
        unsigned* bar = b.bar;
        __builtin_amdgcn_s_waitcnt(0);
        unsigned nloc = b.st[0], nx = b.st[1];
        if (nloc == 0u) { xcd_barrier_complete(bar, b.x, nloc, nx); b.st[0] = nloc; b.st[1] = nx; }
        const unsigned old = xb_add(&bar[XB_XSUB(b.x)], 1u);
        const unsigned gen = old / nloc;
        if (old + 1u == (gen + 1u) * nloc) {
            __builtin_amdgcn_fence(__ATOMIC_RELEASE, "agent");
            asm volatile("s_waitcnt vmcnt(0)" ::: "memory");
            const unsigned og = xb_add(&bar[XB_TOP], 1u);
            const unsigned tg = og / nx;
            if (og + 1u == (tg + 1u) * nx) xb_add(&bar[XB_TOPGEN], 1u);
            else XB_SPIN(xb_ld(&bar[XB_TOPGEN]) == tg, bar);
            __builtin_amdgcn_fence(__ATOMIC_ACQUIRE, "agent");
            xb_add(&bar[XB_XGEN(b.x)], 1u);
            asm volatile("s_waitcnt vmcnt(0)" ::: "memory");
        } else {
            XB_SPIN(xb_ld(&bar[XB_XGEN(b.x)]) == gen, bar);
            __builtin_amdgcn_fence(__ATOMIC_ACQUIRE, "agent");
            asm volatile("s_waitcnt vmcnt(0)" ::: "memory");
        }
    }
    __syncthreads();
}

template <class F> __device__ __forceinline__ void prep_mat(bf16_t* dst, int N, int K, F f) {
    const int kc = K >> 3, total = N * kc; const int gsz = nblk_() * NTHR;
    for (int i = bid_() * NTHR + tid_(); i < total; i += gsz) { const int n = i % N, k0 = (i / N) << 3; float v[8];
#pragma unroll
        for (int j = 0; j < 8; ++j) v[j] = f(n, k0 + j);
        *(u32x4*)(dst + (size_t)n * K + k0) = pack8(v); }
}
__device__ __forceinline__ void phase_weights(CParams& P) {
    { float* cs = (float*)(P.ws + WS_ROPE); float* sn = cs + SEQ * 16; const int gsz = nblk_() * NTHR;
      for (int i = bid_() * NTHR + tid_(); i < SEQ * 16; i += gsz) { const int pos = i >> 4, j = i & 15;
          const double turns = (double)((float)pos * P.invf[j]) * 0.15915494309189535; const float fr = (float)(turns - floor(turns));
          cs[i] = __builtin_amdgcn_cosf(fr); sn[i] = __builtin_amdgcn_sinf(fr); } }
    for (int l = 0; l < DEPTH; ++l) { unsigned char* wb = P.ws + WS_W + (size_t)l * WL_SIZE;
        { const float* w = P.in[3] + (size_t)l * DM * NIN; prep_mat((bf16_t*)(wb + WL_IN), NINP, 1024, [=](int n, int k) { return n < NIN ? w[(size_t)k * NIN + n] : 0.f; }); }
        { const float* w = P.in[5] + (size_t)l * 2 * 64 * 512; prep_mat((bf16_t*)(wb + WL_DEC), 1024, 128, [=](int n, int k) { const int dir = n >> 9; return (k >> 6) == dir ? w[(size_t)dir * 64 * 512 + (k & 63) * 512 + (n & 511)] : 0.f; }); }
        { const float* w = P.in[7] + (size_t)l * 2 * 64 * 512; prep_mat((bf16_t*)(wb + WL_ICL), 1024, 128, [=](int n, int k) { const int dir = n >> 9; return (k >> 6) == dir ? w[(size_t)dir * 64 * 512 + (k & 63) * 512 + (n & 511)] : 0.f; }); }
        { const float* w = P.in[9] + (size_t)l * 160 * 512; prep_mat((bf16_t*)(wb + WL_GATE), 512, 256, [=](int n, int k) { return k < 160 ? w[(size_t)k * 512 + n] : 0.f; }); }
        { const float* w = P.in[17] + (size_t)l * 256 * 768; const float* g = P.in[16] + l * 256; prep_mat((bf16_t*)(wb + WL_UQ), 768, 256, [=](int n, int k) { return g[k] * w[(size_t)k * 768 + n]; }); }
        { const float* w = P.in[19] + (size_t)l * 128 * 1024; const float* g = P.in[18] + l * 128; prep_mat((bf16_t*)(wb + WL_UKV), 1024, 128, [=](int n, int k) { return g[k] * w[(size_t)k * 1024 + n]; }); }
        { const float* w = P.in[15] + (size_t)l * 512 * 1024; prep_mat((bf16_t*)(wb + WL_OA), 1024, 512, [=](int n, int k) { return w[(size_t)k * 1024 + n]; }); }
        { const float* w = P.in[20] + (size_t)l * 512 * 1024; prep_mat((bf16_t*)(wb + WL_OB), 1024, 512, [=](int n, int k) { return w[(size_t)k * 1024 + n]; }); }
        { const float* w = P.in[21] + (size_t)l * 1024 * 1024; prep_mat((bf16_t*)(wb + WL_OUT), 1024, 1024, [=](int n, int k) { return w[(size_t)k * 1024 + n]; }); }
        { const float* w = P.in[23] + (size_t)l * 1024 * NGU; prep_mat((bf16_t*)(wb + WL_GU), NGU, 1024, [=](int n, int k) { const int j = (n >> 5) * 16 + (n & 15); const int col = (n & 16) ? DFF + j : j; return w[(size_t)k * NGU + col]; }); }
        { const float* w = P.in[24] + (size_t)l * DFF * 1024; prep_mat((bf16_t*)(wb + WL_DOWN), 1024, DFF, [=](int n, int k) { return w[(size_t)k * 1024 + n]; }); }
    }
}
__device__ __forceinline__ void phase_norm(const float* x, const float* g, bf16_t* H) {
    const int tid = tid_(), lane = tid & 63, gw = bid_() * NWAVES + (tid >> 6), nw = nblk_() * NWAVES;
    f32x4 gv[4];
#pragma unroll
    for (int j = 0; j < 4; ++j) gv[j] = *((const f32x4*)g + lane + 64 * j);
    f32x4 nv[4], nu[4];
    { const f32x4* xr = (const f32x4*)(x + (size_t)gw * DM) + lane; const f32x4* xq = (const f32x4*)(x + (size_t)(gw + nw) * DM) + lane;
#pragma unroll
      for (int j = 0; j < 4; ++j) { nv[j] = xr[64 * j]; nu[j] = xq[64 * j]; } }
#pragma unroll 1
    for (int r = gw; r < TG; r += 2 * nw) { const int r2 = r + nw;
        f32x4 v[4], u[4]; float s = 0.f, s2 = 0.f;
#pragma unroll
        for (int j = 0; j < 4; ++j) { v[j] = nv[j]; u[j] = nu[j]; }
        if (r + 2 * nw < TG) { const f32x4* xr = (const f32x4*)(x + (size_t)(r + 2 * nw) * DM) + lane; const f32x4* xq = (const f32x4*)(x + (size_t)(r2 + 2 * nw) * DM) + lane;
#pragma unroll
            for (int j = 0; j < 4; ++j) { nv[j] = xr[64 * j]; nu[j] = xq[64 * j]; } }
#pragma unroll
        for (int j = 0; j < 4; ++j) { s += (v[j].x * v[j].x + v[j].y * v[j].y) + (v[j].z * v[j].z + v[j].w * v[j].w); s2 += (u[j].x * u[j].x + u[j].y * u[j].y) + (u[j].z * u[j].z + u[j].w * u[j].w); }
        const float rstd = __builtin_amdgcn_rsqf(wave_sum(s) * (1.0f / DM) + 1e-6f), rstd2 = __builtin_amdgcn_rsqf(wave_sum(s2) * (1.0f / DM) + 1e-6f);
        u32x2* o = (u32x2*)(H + (size_t)r * DM) + lane; u32x2* o2 = (u32x2*)(H + (size_t)r2 * DM) + lane;
#pragma unroll
        for (int j = 0; j < 4; ++j) { const f32x4 y = v[j] * rstd * gv[j], z = u[j] * rstd2 * gv[j]; u32x2 w, w2; w.x = cvtpk(y.x, y.y); w.y = cvtpk(y.z, y.w); w2.x = cvtpk(z.x, z.y); w2.y = cvtpk(z.z, z.w); o[64 * j] = w; o2[64 * j] = w2; } }
}
__device__ __forceinline__ void phase_final_norm(float* x, const float* g) {
    const int tid = tid_(), lane = tid & 63, gw = bid_() * NWAVES + (tid >> 6), nw = nblk_() * NWAVES;
    f32x4 gv[4];
#pragma unroll
    for (int j = 0; j < 4; ++j) gv[j] = *((const f32x4*)g + lane + 64 * j);
    f32x4 nv[4], nu[4];
    { const f32x4* xr = (const f32x4*)(x + (size_t)gw * DM) + lane; const f32x4* xq = (const f32x4*)(x + (size_t)(gw + nw) * DM) + lane;
#pragma unroll
      for (int j = 0; j < 4; ++j) { nv[j] = xr[64 * j]; nu[j] = xq[64 * j]; } }
#pragma unroll 1
    for (int r = gw; r < TG; r += 2 * nw) { const int r2 = r + nw; f32x4 v[4], u[4]; float s = 0.f, s2 = 0.f;
#pragma unroll
        for (int j = 0; j < 4; ++j) { v[j] = nv[j]; u[j] = nu[j]; }
        if (r + 2 * nw < TG) { const f32x4* yr = (const f32x4*)(x + (size_t)(r + 2 * nw) * DM) + lane; const f32x4* yq = (const f32x4*)(x + (size_t)(r2 + 2 * nw) * DM) + lane;
#pragma unroll
            for (int j = 0; j < 4; ++j) { nv[j] = yr[64 * j]; nu[j] = yq[64 * j]; } }
        f32x4* xr = (f32x4*)(x + (size_t)r * DM) + lane; f32x4* xq = (f32x4*)(x + (size_t)r2 * DM) + lane;
#pragma unroll
        for (int j = 0; j < 4; ++j) { s += (v[j].x * v[j].x + v[j].y * v[j].y) + (v[j].z * v[j].z + v[j].w * v[j].w); s2 += (u[j].x * u[j].x + u[j].y * u[j].y) + (u[j].z * u[j].z + u[j].w * u[j].w); }
        const float rstd = __builtin_amdgcn_rsqf(wave_sum(s) * (1.0f / DM) + 1e-6f), rstd2 = __builtin_amdgcn_rsqf(wave_sum(s2) * (1.0f / DM) + 1e-6f);
#pragma unroll
        for (int j = 0; j < 4; ++j) { xr[64 * j] = v[j] * rstd * gv[j]; xq[64 * j] = u[j] * rstd2 * gv[j]; } }
}
__device__ __forceinline__ void shift8(u32x4 cw, u32x4 pw, u32x4 nw, const float* m0, const float* m1, float* out) {
    float c[8], pv[8], nx[8]; unpack8(cw, c); unpack8(pw, pv); unpack8(nw, nx);
#pragma unroll
    for (int i = 0; i < 8; ++i) out[i] = c[i] + m0[i] * (pv[i] - c[i]) + m1[i] * (nx[i] - c[i]);
}
__device__ __forceinline__ f16x8 tof16x8(const float* v) { f16x8 o;
#pragma unroll
    for (int i = 0; i < 8; ++i) o[i] = (f16)v[i];
    return o; }
struct PrepRaw { u32x4 cr, pr, nr, ck, pk, nk, cv, pv, nv, cb, pb, nb, cm; };
__device__ __forceinline__ PrepRaw prep_load(const bf16_t* P2, int tok, int lane, int colB) {
    const int t = tok & (SEQ - 1); const bool hp = t > 0, hn = t < SEQ - 1; const bf16_t* row = P2 + (size_t)tok * NP2;
    const bf16_t* rp = hp ? row - NP2 : row; const bf16_t* rn = hn ? row + NP2 : row; const u32x4 z4 = {0, 0, 0, 0}; PrepRaw x;
    x.cr = *(const u32x4*)(row + 8 * lane); x.pr = *(const u32x4*)(rp + 8 * lane); x.nr = *(const u32x4*)(rn + 8 * lane);
    x.ck = *(const u32x4*)(row + 512 + 8 * lane); x.pk = *(const u32x4*)(rp + 512 + 8 * lane); x.nk = *(const u32x4*)(rn + 512 + 8 * lane);
    x.cv = *(const u32x4*)(row + 1024 + 8 * lane); x.pv = *(const u32x4*)(rp + 1024 + 8 * lane); x.nv = *(const u32x4*)(rn + 1024 + 8 * lane);
    x.cb = *(const u32x4*)(row + colB); x.pb = *(const u32x4*)(rp + colB); x.nb = *(const u32x4*)(rn + colB);
    x.cm = *(const u32x4*)(row + 1952 + 8 * (lane < 52 ? lane : 0));
    if (!hp) { x.pr = z4; x.pk = z4; x.pv = z4; x.pb = z4; }
    if (!hn) { x.nr = z4; x.nk = z4; x.nv = z4; x.nb = z4; }
    return x;
}
__device__ __forceinline__ void phase_prep(CParams& P, int l) {
    const int tid = tid_(), lane = tid & 63, gw = bid_() * NWAVES + (tid >> 6), nw = nblk_() * NWAVES;
    const bf16_t* P2 = (const bf16_t*)(P.ws + WS_P2); f16* SC = (f16*)(P.ws + WS_SC); f16* V16 = (f16*)(P.ws + WS_V16); bf16_t* LIN = (bf16_t*)(P.ws + WS_LIN);
    float* rq = (float*)(P.ws + WS_RSTD); float* rkv = rq + TG; float* bs = (float*)(P.ws + WS_BS); bf16_t* KF = (bf16_t*)(P.ws + WS_KF);
    const float* cs = (const float*)(P.ws + WS_ROPE); const float* sn = cs + SEQ * 16;
    const float* mu = P.in[4] + (size_t)l * 2 * 1952; const float* kkw = P.in[10] + l * 512 + 8 * lane; const float* rkw = P.in[12] + l * 512 + 8 * lane;
    const int colB = 1536 + 8 * (lane < 52 ? lane : 0);
    float mr0[8], mr1[8], mk0[8], mk1[8], mv0[8], mv1[8], mb0[8], mb1[8], kkv[8], rkv8[8];
#pragma unroll
    for (int i = 0; i < 8; ++i) { mr0[i] = mu[8 * lane + i]; mr1[i] = mu[1952 + 8 * lane + i]; mk0[i] = mu[512 + 8 * lane + i]; mk1[i] = mu[1952 + 512 + 8 * lane + i];
        mv0[i] = mu[1024 + 8 * lane + i]; mv1[i] = mu[1952 + 1024 + 8 * lane + i]; mb0[i] = mu[colB + i]; mb1[i] = mu[1952 + colB + i]; kkv[i] = kkw[i]; rkv8[i] = rkw[i]; }
    PrepRaw nxt = prep_load(P2, gw, lane, colB);
#pragma unroll 1
    for (int tok = gw; tok < TG; tok += nw) { const int t = tok & (SEQ - 1); const PrepRaw x = nxt;
        if (tok + nw < TG) nxt = prep_load(P2, tok + nw, lane, colB);
        float csv[8], snv[8];
        { const int j0 = (lane & 1) * 8; const f32x4 c0 = *(const f32x4*)(cs + t * 16 + j0), c1 = *(const f32x4*)(cs + t * 16 + j0 + 4), s0 = *(const f32x4*)(sn + t * 16 + j0), s1 = *(const f32x4*)(sn + t * 16 + j0 + 4);
#pragma unroll
          for (int i = 0; i < 4; ++i) { csv[i] = c0[i]; csv[4 + i] = c1[i]; snv[i] = s0[i]; snv[4 + i] = s1[i]; } }
        { float r8[8], k8[8], v8[8], kk8[8]; shift8(x.cr, x.pr, x.nr, mr0, mr1, r8); shift8(x.ck, x.pk, x.nk, mk0, mk1, k8); shift8(x.cv, x.pv, x.nv, mv0, mv1, v8);
          float ss = 0.f, bsum = 0.f;
#pragma unroll
          for (int i = 0; i < 8; ++i) { kk8[i] = k8[i] * kkv[i]; ss += kk8[i] * kk8[i]; bsum += r8[i] * k8[i] * rkv8[i]; }
          ss = sum8(ss); bsum = sum8(bsum); const float inv = __builtin_amdgcn_rsqf(fmaxf(ss, 1e-24f));
#pragma unroll
          for (int i = 0; i < 8; ++i) kk8[i] *= inv;
          const int head = lane >> 3, d0 = (lane & 7) * 8; const f16x8 rh = tof16x8(r8), kh = tof16x8(k8), kkh = tof16x8(kk8);
          { f16* p = SC + ((size_t)tok * 8 + head) * 192 + d0; *(f16x8*)(p) = rh; *(f16x8*)(p + 64) = kh; *(f16x8*)(p + 128) = kkh; }
          *(f16x8*)(V16 + (size_t)tok * 512 + 8 * lane) = tof16x8(v8);
          if ((lane & 7) == 0) bs[tok * 8 + head] = bsum; }
        { float o[8];
          if (lane < 52) { shift8(x.cb, x.pb, x.nb, mb0, mb1, o);
              if (lane < 16) {
#pragma unroll
                  for (int i = 0; i < 8; ++i) o[i] = 2.0f * sigmoidf_(2.0f * o[i]) - 1.0f; }
              else if (lane >= 32) {
#pragma unroll
                  for (int i = 0; i < 8; ++i) o[i] = sigmoidf_(o[i]); } }
          else {
#pragma unroll
              for (int i = 0; i < 8; ++i) o[i] = 0.f; }
          *(u32x4*)(LIN + (size_t)tok * 512 + 8 * lane) = pack8(o); }
        { float xv[8]; float ss = 0.f; unpack8(x.cm, xv);
          if (lane < 52) {
#pragma unroll
              for (int i = 0; i < 8; ++i) ss += xv[i] * xv[i]; }
          const float rs16 = red16(ss);
          const int rsi = __builtin_bit_cast(int, rs16); const float sq = __builtin_bit_cast(float, __builtin_amdgcn_readlane(rsi, 0)) + __builtin_bit_cast(float, __builtin_amdgcn_readlane(rsi, 16)), skv = __builtin_bit_cast(float, __builtin_amdgcn_readlane(rsi, 32));
          if (lane == 0) { rq[tok] = __builtin_amdgcn_rsqf(sq * (1.0f / 256.0f) + 1e-6f); rkv[tok] = __builtin_amdgcn_rsqf(skv * (1.0f / 128.0f) + 1e-6f); }
          float y[8];
#pragma unroll
          for (int i = 0; i < 8; ++i) y[i] = DPP_F(xv[i], 0x4E);
          if (lane >= 48 && lane < 52) { const int half = (lane - 48) >> 1; float o[8];
#pragma unroll
              for (int i = 0; i < 8; ++i) o[i] = half ? (xv[i] * csv[i] + y[i] * snv[i]) : (xv[i] * csv[i] - y[i] * snv[i]);
              const u32x4 w = pack8(o);
#pragma unroll
              for (int h = 0; h < 8; ++h) *(u32x4*)(KF + (size_t)tok * 768 + h * 96 + 64 + (lane - 48) * 8) = w; } }
    }
}
__device__ __forceinline__ void phase_post(CParams& P, int l) {
    const int tid = tid_(), lane = tid & 63, gw = bid_() * NWAVES + (tid >> 6), nw = nblk_() * NWAVES;
    const float* OF = (const float*)(P.ws + WS_P2); const float* OB = OF + (size_t)TG * 512; const f16* V16 = (const f16*)(P.ws + WS_V16);
    const bf16_t* G = (const bf16_t*)(P.ws + WS_G); bf16_t* YA = (bf16_t*)(P.ws + WS_LIN); const float* bs = (const float*)(P.ws + WS_BS);
    const float* gg = P.in[13] + l * 512 + 8 * lane; const float* gb = P.in[14] + l * 512 + 8 * lane;
    float ggv[8], gbv[8];
#pragma unroll
    for (int i = 0; i < 8; ++i) { ggv[i] = gg[i]; gbv[i] = gb[i]; }
#pragma unroll 1
    for (int tok = gw; tok < TG; tok += 2 * nw) { const size_t off = (size_t)tok * 512 + 8 * lane, off2 = off + (size_t)nw * 512; float o[8], g[8], p[8], h[8];
        const f32x4 a0 = *(const f32x4*)(OF + off), a1 = *(const f32x4*)(OF + off + 4), b0 = *(const f32x4*)(OB + off), b1 = *(const f32x4*)(OB + off + 4);
        const f32x4 c0 = *(const f32x4*)(OF + off2), c1 = *(const f32x4*)(OF + off2 + 4), d0 = *(const f32x4*)(OB + off2), d1 = *(const f32x4*)(OB + off2 + 4);
        const f16x8 v = *(const f16x8*)(V16 + off), v2 = *(const f16x8*)(V16 + off2); const u32x4 gw4 = *(const u32x4*)(G + off), gw42 = *(const u32x4*)(G + off2);
        const float bon = bs[tok * 8 + (lane >> 3)], bon2 = bs[(tok + nw) * 8 + (lane >> 3)];
#pragma unroll
        for (int i = 0; i < 4; ++i) { o[i] = a0[i] + b0[i]; o[4 + i] = a1[i] + b1[i]; p[i] = c0[i] + d0[i]; p[4 + i] = c1[i] + d1[i]; }
        float s = 0.f, s2 = 0.f;
#pragma unroll
        for (int i = 0; i < 8; ++i) { s += o[i]; s2 += p[i]; }
        const float mean = sum8(s) * (1.0f / 64.0f), mean2 = sum8(s2) * (1.0f / 64.0f); float q = 0.f, q2 = 0.f;
#pragma unroll
        for (int i = 0; i < 8; ++i) { o[i] -= mean; q += o[i] * o[i]; p[i] -= mean2; q2 += p[i] * p[i]; }
        const float rstd = __builtin_amdgcn_rsqf(sum8(q) * (1.0f / 64.0f) + 64e-5f), rstd2 = __builtin_amdgcn_rsqf(sum8(q2) * (1.0f / 64.0f) + 64e-5f);
        unpack8(gw4, g); unpack8(gw42, h);
#pragma unroll
        for (int i = 0; i < 8; ++i) { o[i] = (o[i] * rstd * ggv[i] + gbv[i] + bon * (float)v[i]) * g[i]; p[i] = (p[i] * rstd2 * ggv[i] + gbv[i] + bon2 * (float)v2[i]) * h[i]; }
        *(u32x4*)(YA + off) = pack8(o); *(u32x4*)(YA + off2) = pack8(p); }
}
#define MFMA32(a, b, c) __builtin_amdgcn_mfma_f32_32x32x16_bf16((a), (b), (c), 0, 0, 0)
#define AT_BAR() do { asm volatile("s_waitcnt lgkmcnt(0)" ::: "memory"); __builtin_amdgcn_s_barrier(); asm volatile("" ::: "memory"); } while (0)
__device__ __forceinline__ void phase_attn(CParams& P, LAS unsigned char* lds) {
    const int tid = tid_(), lane = tid & 63, wid = tid >> 6, ql = lane & 31, hi = lane >> 5;
    const bf16_t* Q = (const bf16_t*)(P.ws + WS_Q); const bf16_t* KF = (const bf16_t*)(P.ws + WS_KF); const bf16_t* VT = (const bf16_t*)(P.ws + WS_VT); bf16_t* O = (bf16_t*)(P.ws + WS_OATT);
    const int G = nblk_(), bx = bid_(); const int vcu = (G % 8 == 0) ? (bx % 8) * (G / 8) + bx / 8 : bx;
    constexpr int KROW = 208, VROW = 272, KBUF = 128 * KROW, VBUF = 64 * VROW, VOFF = 2 * KBUF, NT = SEQ / 128;
    static_assert(VOFF + 2 * VBUF <= 131072, "attention LDS map");
    const int kr0 = tid / 12, kc0 = tid % 12, kr1 = (512 + tid) / 12, kc1 = (512 + tid) % 12, kr2 = (1024 + tid) / 12, kc2 = (1024 + tid) % 12, vr0 = tid >> 4, vc0 = tid & 15, vr1 = 32 + vr0, vgo = (vc0 >> 1) * 32 + (vc0 & 1) * 8;
#define AT_GLOAD(kt) do { ka = *(const u32x4*)(kg0 + (size_t)(kt) * 128 * 768); kb = *(const u32x4*)(kg1 + (size_t)(kt) * 128 * 768); kc = *(const u32x4*)(kg2 + (size_t)(kt) * 128 * 768); \
        va = *(const u32x4*)(vg0 + (kt) * 128); vb = *(const u32x4*)(vg1 + (kt) * 128); } while (0)
#define AT_LWRITE(nb) do { LAS unsigned char* kq = lds + (nb) * KBUF; LAS unsigned char* vq = lds + VOFF + (nb) * VBUF; \
        *(LAS u32x4*)(kq + kr0 * KROW + kc0 * 16) = ka; *(LAS u32x4*)(kq + kr1 * KROW + kc1 * 16) = kb; *(LAS u32x4*)(kq + kr2 * KROW + kc2 * 16) = kc; \
        *(LAS u32x2*)(vq + vr0 * VROW + vgo) = (u32x2){va.x, va.y}; *(LAS u32x2*)(vq + vr0 * VROW + vgo + 16) = (u32x2){va.z, va.w}; \
        *(LAS u32x2*)(vq + vr1 * VROW + vgo) = (u32x2){vb.x, vb.y}; *(LAS u32x2*)(vq + vr1 * VROW + vgo + 16) = (u32x2){vb.z, vb.w}; } while (0)
#define AT_KFRAG(buf, sub) do { const LAS unsigned char* kb_ = lds + (buf) * KBUF + ((sub) * 64 + ql) * KROW + hi * 16; _Pragma("unroll") for (int ds = 0; ds < 6; ++ds) { \
        kfa[ds] = *(const LAS bf16x8*)(kb_ + ds * 32); kfb[ds] = *(const LAS bf16x8*)(kb_ + 32 * KROW + ds * 32); } } while (0)
#define AT_QK(S) do { const f32x16 zz = {}; S##0 = MFMA32(kfa[0], qf[0], zz); S##1 = MFMA32(kfb[0], qf[0], zz); _Pragma("unroll") for (int ds = 1; ds < 6; ++ds) { \
        S##0 = MFMA32(kfa[ds], qf[ds], S##0); S##1 = MFMA32(kfb[ds], qf[ds], S##1); } } while (0)
#define AT_VFRAG(buf, sub) do { const LAS unsigned char* vb_ = lds + VOFF + (buf) * VBUF + ql * VROW + (sub) * 128 + hi * 16; _Pragma("unroll") for (int ks = 0; ks < 4; ++ks) { \
        vfa[ks] = *(const LAS bf16x8*)(vb_ + ks * 32); vfb[ks] = *(const LAS bf16x8*)(vb_ + 32 * VROW + ks * 32); } } while (0)
#define AT_PV() do { _Pragma("unroll") for (int ks = 0; ks < 4; ++ks) { o0 = MFMA32(vfa[ks], pf[ks], o0); o1 = MFMA32(vfb[ks], pf[ks], o1); } } while (0)
#define AT_SM(S, N, FIXN, first) do { \
        float mxa = __builtin_fmaxf(__builtin_fmaxf(S##0[0], S##0[1]), S##1[0]), mxb = __builtin_fmaxf(__builtin_fmaxf(S##0[2], S##0[3]), S##1[1]); mxa = __builtin_fmaxf(__builtin_fmaxf(mxa, S##1[2]), S##1[3]); \
        _Pragma("unroll") for (int r = 4; r < 16; r += 4) { mxa = __builtin_fmaxf(__builtin_fmaxf(mxa, S##0[r]), S##0[r + 1]); mxb = __builtin_fmaxf(__builtin_fmaxf(mxb, S##0[r + 2]), S##0[r + 3]); \
            mxa = __builtin_fmaxf(__builtin_fmaxf(mxa, S##1[r]), S##1[r + 1]); mxb = __builtin_fmaxf(__builtin_fmaxf(mxb, S##1[r + 2]), S##1[r + 3]); } \
        float mx = __builtin_fmaxf(mxa, mxb); { const auto rr_ = __builtin_amdgcn_permlane32_swap(__float_as_uint(mx), __float_as_uint(mx), false, false); mx = __builtin_fmaxf(__uint_as_float(rr_[0]), __uint_as_float(rr_[1])); } const float rel = mx - mrun; \
        if (__any(rel > 8.0f || ((first) && rel < -8.0f))) { const float dl = (first) ? ((rel > 8.0f || rel < -8.0f) ? rel : 0.f) : fmaxf(rel, 0.f); const float alpha = (first) ? 0.f : __builtin_amdgcn_exp2f(-dl); mrun += dl; lrun *= alpha; \
            _Pragma("unroll") for (int r = 0; r < 16; ++r) { o0[r] *= alpha; o1[r] *= alpha; } } \
        if (__any(mrun != 0.f)) { _Pragma("unroll") for (int r = 0; r < 16; ++r) { S##0[r] -= mrun; S##1[r] -= mrun; } } \
        _Pragma("unroll") for (int r = 0; r < 16; ++r) { S##0[r] = __builtin_amdgcn_exp2f(S##0[r]); S##1[r] = __builtin_amdgcn_exp2f(S##1[r]); } \
        { f32x2 pa = (f32x2){S##0[0], S##0[1]} + (f32x2){S##0[2], S##0[3]}, pb = (f32x2){S##1[0], S##1[1]} + (f32x2){S##1[2], S##1[3]}; \
          _Pragma("unroll") for (int r = 4; r < 16; r += 4) { pa += (f32x2){S##0[r], S##0[r + 1]}; pb += (f32x2){S##1[r], S##1[r + 1]}; pa += (f32x2){S##0[r + 2], S##0[r + 3]}; pb += (f32x2){S##1[r + 2], S##1[r + 3]}; } \
          pa += pb; lrun += pa[0] + pa[1]; } \
        _Pragma("unroll") for (int j = 0; j < 2; ++j) { u32x4 w0, w1; \
            w0.x = cvtpk(S##0[8 * j], S##0[8 * j + 1]); w0.y = cvtpk(S##0[8 * j + 2], S##0[8 * j + 3]); w0.z = cvtpk(S##0[8 * j + 4], S##0[8 * j + 5]); w0.w = cvtpk(S##0[8 * j + 6], S##0[8 * j + 7]); \
            w1.x = cvtpk(S##1[8 * j], S##1[8 * j + 1]); w1.y = cvtpk(S##1[8 * j + 2], S##1[8 * j + 3]); w1.z = cvtpk(S##1[8 * j + 4], S##1[8 * j + 5]); w1.w = cvtpk(S##1[8 * j + 6], S##1[8 * j + 7]); \
            pf[j] = __builtin_bit_cast(bf16x8, w0); pf[2 + j] = __builtin_bit_cast(bf16x8, w1); } } while (0)
    for (int u = vcu; u < GSEQ * 8 * 16; u += G) {
        const int sh = u >> 4, qb = u & 15, s = sh >> 3, h = sh & 7; const size_t tok0 = (size_t)s * SEQ;
        bf16x8 qf[6]; { const bf16_t* qp = Q + (tok0 + qb * 256 + wid * 32 + ql) * 768 + h * 96 + 8 * hi;
#pragma unroll
            for (int ds = 0; ds < 6; ++ds) qf[ds] = *(const bf16x8*)(qp + 16 * ds); }
        const bf16_t* kg0 = KF + (tok0 + kr0) * 768 + h * 96 + kc0 * 8; const bf16_t* kg1 = KF + (tok0 + kr1) * 768 + h * 96 + kc1 * 8; const bf16_t* kg2 = KF + (tok0 + kr2) * 768 + h * 96 + kc2 * 8;
        const bf16_t* vg0 = VT + ((size_t)(s * 8 + h) * 64 + vr0) * SEQ + vc0 * 8; const bf16_t* vg1 = vg0 + (size_t)32 * SEQ;
        u32x4 ka, kb, kc, va, vb;
        f32x16 o0 = {}, o1 = {}, pA0, pA1; float mrun = 0.f, lrun = 0.f; bf16x8 pf[4], kfa[6], kfb[6], vfa[4], vfb[4];
        AT_GLOAD(0); AT_LWRITE(0);
        AT_BAR();
#pragma unroll 1
        for (int kt = 0; kt < NT; ++kt) { const int cur = kt & 1;
            if (kt + 1 < NT) AT_GLOAD(kt + 1);
            AT_KFRAG(cur, 0);
            AT_QK(pA); AT_VFRAG(cur, 0); AT_SM(pA, pA, false, kt == 0); AT_KFRAG(cur, 1); AT_PV();
            AT_QK(pA); AT_VFRAG(cur, 1); AT_SM(pA, pA, false, false); AT_PV();
            if (kt + 1 < NT) AT_LWRITE(cur ^ 1);
            AT_BAR(); }
        { const auto rr_ = __builtin_amdgcn_permlane32_swap(__float_as_uint(lrun), __float_as_uint(lrun), false, false); lrun = __uint_as_float(rr_[0]) + __uint_as_float(rr_[1]); } const float inv = 1.0f / lrun;
        bf16_t* op = O + (tok0 + qb * 256 + wid * 32 + ql) * 512 + h * 64 + 4 * hi;
#pragma unroll
        for (int g = 0; g < 4; ++g) { u32x2 w0, w1; w0.x = cvtpk(o0[4 * g] * inv, o0[4 * g + 1] * inv); w0.y = cvtpk(o0[4 * g + 2] * inv, o0[4 * g + 3] * inv);
            w1.x = cvtpk(o1[4 * g] * inv, o1[4 * g + 1] * inv); w1.y = cvtpk(o1[4 * g + 2] * inv, o1[4 * g + 3] * inv);
            *(u32x2*)(op + 8 * g) = w0; *(u32x2*)(op + 32 + 8 * g) = w1; }
    }
    __syncthreads();
#undef AT_GLOAD
#undef AT_LWRITE
#undef AT_KFRAG
#undef AT_QK
#undef AT_VFRAG
#undef AT_PV
#undef AT_SM
}
__device__ __forceinline__ void phase_scan(CParams& P, LAS unsigned char* lds) {
    const int tid = tid_(), lane = tid & 63, wid = tid >> 6; const int nb_ = nblk_();
    const f16* SC = (const f16*)(P.ws + WS_SC); const f16* SCD = (const f16*)(P.ws + WS_SCD); const f16* V16 = (const f16*)(P.ws + WS_V16);
    constexpr int STEPF = 352, CH = 32, NCH = SEQ / CH, BUFF = CH * STEPF;
    LAS float* lf = (LAS float*)lds;
    const int bx_ = bid_(); const int vcu_ = (nb_ % 8 == 0) ? (bx_ % 8) * (nb_ / 8) + bx_ / 8 : bx_;
    for (int task = vcu_; task < GSEQ * 8 * 2 * 2; task += nb_) {
        const int rowhalf = task & 1, dir = (task >> 1) & 1, h = (task >> 2) & 7, s = task >> 5;
        float* OUT = (float*)(P.ws + WS_P2) + (size_t)dir * TG * 512;
        __syncthreads();
        if (wid >= 4) {
            const int ltid = tid - 256; f16x8 v[6];
#define SC_GLOAD(cn) do { _Pragma("unroll") for (int i = 0; i < 6; ++i) { const int p = ltid + 256 * i; if (p < CH * 44) { const int j = p / 44, q = p - j * 44; const int st = (cn) * CH + j; const int t = dir ? (SEQ - 1 - st) : st; const size_t tok = (size_t)s * SEQ + t; \
                const f16* ss_ = SC + (tok * 8 + h) * 192; const f16* sd_ = SCD + (((size_t)dir * TG + tok) * 8 + h) * 192; \
                const f16* src = q < 8 ? ss_ + q * 8 : q < 24 ? sd_ + (q - 8) * 8 : q < 32 ? ss_ + 128 + (q - 24) * 8 : q < 40 ? sd_ + 128 + (q - 32) * 8 : V16 + tok * 512 + h * 64 + rowhalf * 32 + (q - 40) * 8; v[i] = *(const f16x8*)src; } } } while (0)
#define SC_WRITE(cn) do { LAS float* dst = lf + ((cn) & 1) * BUFF; _Pragma("unroll") for (int i = 0; i < 6; ++i) { const int p = ltid + 256 * i; if (p < CH * 44) { const int j = p / 44, q = p - j * 44; LAS float* d = dst + j * STEPF + q * 8; \
                *(LAS f32x4*)d = (f32x4){(float)v[i][0], (float)v[i][1], (float)v[i][2], (float)v[i][3]}; *(LAS f32x4*)(d + 4) = (f32x4){(float)v[i][4], (float)v[i][5], (float)v[i][6], (float)v[i][7]}; } } } while (0)
            SC_GLOAD(0); SC_WRITE(0); SC_GLOAD(1);
#pragma unroll 1
            for (int c = 0; c < NCH; ++c) {
                __syncthreads();
                if (c + 1 < NCH) { SC_WRITE(c + 1); if (c + 2 < NCH) SC_GLOAD(c + 2); }
            }
            __syncthreads();
#undef SC_GLOAD
#undef SC_WRITE
        } else {
            const int rl = lane >> 3, oct = lane & 7, rloc = wid * 8 + rl;
            __builtin_amdgcn_s_setprio(3);
            f32x4 s0 = {0.f, 0.f, 0.f, 0.f}, s1 = {0.f, 0.f, 0.f, 0.f};
            float* op = OUT + ((size_t)s * SEQ + (dir ? SEQ - 1 : 0)) * 512 + h * 64 + rowhalf * 32 + rloc; const long ostep = dir ? -512 : 512;
#define SC_LOAD(X, sp) do { X##r0 = *(const LAS f32x4*)(sp); X##r1 = *(const LAS f32x4*)((sp) + 4); X##w0 = *(const LAS f32x4*)((sp) + 64); X##w1 = *(const LAS f32x4*)((sp) + 68); \
        X##k0 = *(const LAS f32x4*)((sp) + 128); X##k1 = *(const LAS f32x4*)((sp) + 132); X##q0 = *(const LAS f32x4*)((sp) + 192); X##q1 = *(const LAS f32x4*)((sp) + 196); \
        X##b0 = *(const LAS f32x4*)((sp) + 256); X##b1 = *(const LAS f32x4*)((sp) + 260); X##vv = (sp)[320 - 8 * oct + rloc]; } while (0)
#define SC_STEP(X) do { const f32x4 pp = s0 * X##q0 + s1 * X##q1; float sa = (pp[0] + pp[1]) + (pp[2] + pp[3]); \
        const f32x4 c0 = s0 * X##w0 + X##vv * X##k0, c1 = s1 * X##w1 + X##vv * X##k1; sa = red8(sa); \
        s0 = c0 + sa * X##b0; s1 = c1 + sa * X##b1; const f32x4 tt = s0 * X##r0 + s1 * X##r1; float o = (tt[0] + tt[1]) + (tt[2] + tt[3]); o = red8(o); *op = o; op += ostep; } while (0)
            f32x4 Ar0, Ar1, Aw0, Aw1, Ak0, Ak1, Aq0, Aq1, Ab0, Ab1, Br0, Br1, Bw0, Bw1, Bk0, Bk1, Bq0, Bq1, Bb0, Bb1; float Avv, Bvv;
#pragma unroll 1
            for (int c = 0; c < NCH; ++c) {
                __syncthreads();
                const LAS float* base = lf + (c & 1) * BUFF + 8 * oct;
                SC_LOAD(A, base);
#pragma unroll 2
                for (int j = 0; j < CH; j += 2) { const LAS float* sp = base + j * STEPF;
                    SC_LOAD(B, sp + STEPF); SC_STEP(A);
                    SC_LOAD(A, sp + 2 * STEPF);
                    SC_STEP(B); }
            }
#undef SC_LOAD
#undef SC_STEP
            __builtin_amdgcn_s_setprio(0);
            __syncthreads();
        }
    }
    __syncthreads();
}
enum { ST_NORM1 = 0, ST_IN, ST_PREP, ST_DECAY, ST_ICLR, ST_GATE, ST_Q, ST_KV, ST_ATTN, ST_SCAN, ST_POST, ST_OA, ST_OB, ST_OUT, ST_NORM2, ST_GU, ST_DOWN, ST_COUNT };
constexpr int PH_PER_LAYER = ST_COUNT, PH_PER_GROUP = DEPTH * PH_PER_LAYER + 1, N_PHASES = 1 + NGROUP * PH_PER_GROUP;
__host__ __device__ __forceinline__ bool phase_needs_sync(int ph) {
    if (ph == 0) return false;
    const int r = (ph - 1) % PH_PER_GROUP; if (r == DEPTH * PH_PER_LAYER) return true;
    const int st = r % PH_PER_LAYER;
    return !(st == ST_ICLR || st == ST_GATE || st == ST_Q || st == ST_KV || st == ST_SCAN || st == ST_OB);
}
template <class Epi> __device__ __forceinline__ void run_gemm(LAS unsigned char* lds, const bf16_t* A, int lda, const bf16_t* Bt, int N, int K, const Epi& E) {
    int ldb = K; asm volatile("" : "+s"(N), "+s"(K), "+s"(lda), "+s"(ldb));
    pg8::Gemm g{A, Bt, TG, N, K, lda, ldb}; pg8::StaticOrder S; S.init(TG, N, nblk_(), bid_());
    pg8::gemm_phase<Epi, pg8::StaticOrder, true, true>(lds, g, S, E);
}
__device__ __forceinline__ void run_phase(CParams& P, LAS unsigned char* lds, int ph) {
    if (ph == 0) { phase_weights(P); return; }
    const int pg = ph - 1, g = pg / PH_PER_GROUP, r = pg % PH_PER_GROUP;
    float* xo = P.out + (size_t)g * TG * DM;
    if (r == DEPTH * PH_PER_LAYER) { phase_final_norm(xo, P.in[25]); return; }
    const int l = r / PH_PER_LAYER, st = r % PH_PER_LAYER;
    const float* xin = (g < 2) ? P.in[0] + (size_t)g * TG * DM : P.in[1];
    const float* xsrc = (l == 0) ? xin : xo;
    unsigned char* ws = P.ws; const unsigned char* wb = ws + WS_W + (size_t)l * WL_SIZE;
    bf16_t* H = (bf16_t*)(ws + WS_H); bf16_t* P2 = (bf16_t*)(ws + WS_P2); bf16_t* GATES = (bf16_t*)(ws + WS_GATES); f16* SC = (f16*)(ws + WS_SC); f16* SCD = (f16*)(ws + WS_SCD);
    bf16_t* LIN = (bf16_t*)(ws + WS_LIN); const float* rq = (const float*)(ws + WS_RSTD); const float* cs = (const float*)(ws + WS_ROPE);
#ifdef ONLY_STEP
    if (st != ONLY_STEP) return;
#endif
    switch (st) {
    case ST_NORM1: phase_norm(xsrc, P.in[2] + l * DM, H); break;
    case ST_IN: { EpiIn E{GATES, P2}; run_gemm(lds, H, DM, (const bf16_t*)(wb + WL_IN), NINP, DM, E); } break;
    case ST_PREP: phase_prep(P, l); break;
    case ST_DECAY: { EpiDecay E{SCD, P.in[6] + l * 1024}; run_gemm(lds, LIN, 512, (const bf16_t*)(wb + WL_DEC), 1024, 128, E); } break;
    case ST_ICLR: { EpiIclr E{SC, SCD, P.in[8] + l * 1024, P.in[11] + l * 512}; run_gemm(lds, LIN + 128, 512, (const bf16_t*)(wb + WL_ICL), 1024, 128, E); } break;
    case ST_GATE: { EpiPlain E{(bf16_t*)(ws + WS_G), 512}; run_gemm(lds, LIN + 256, 512, (const bf16_t*)(wb + WL_GATE), 512, 256, E); } break;
    case ST_Q: { EpiQ E{(bf16_t*)(ws + WS_Q), rq, cs, cs + SEQ * 16}; run_gemm(lds, P2 + 1952, NP2, (const bf16_t*)(wb + WL_UQ), 768, 256, E); } break;
    case ST_KV: { EpiKV E{(bf16_t*)(ws + WS_KF), (bf16_t*)(ws + WS_VT), rq + TG}; run_gemm(lds, P2 + 2208, NP2, (const bf16_t*)(wb + WL_UKV), 1024, 128, E); } break;
    case ST_ATTN: phase_attn(P, lds); break;
    case ST_SCAN: phase_scan(P, lds); break;
    case ST_POST: phase_post(P, l); break;
    case ST_OA: { EpiMix<0> E{H, GATES}; run_gemm(lds, LIN, 512, (const bf16_t*)(wb + WL_OA), 1024, 512, E); } break;
    case ST_OB: { EpiMix<1> E{H, GATES}; run_gemm(lds, (const bf16_t*)(ws + WS_OATT), 512, (const bf16_t*)(wb + WL_OB), 1024, 512, E); } break;
    case ST_OUT: { EpiRes E{xsrc, xo}; run_gemm(lds, H, DM, (const bf16_t*)(wb + WL_OUT), 1024, 1024, E); } break;
    case ST_NORM2: phase_norm(xo, P.in[22] + l * DM, H); break;
    case ST_GU: { EpiGU E{P2}; run_gemm(lds, H, DM, (const bf16_t*)(wb + WL_GU), NGU, DM, E); } break;
    case ST_DOWN: { EpiRes E{xo, xo}; run_gemm(lds, P2, DFF, (const bf16_t*)(wb + WL_DOWN), 1024, DFF, E); } break;
    }
}
__global__ void __launch_bounds__(NTHR, 2) mk_fwd(Params Punused) {
    extern __shared__ __attribute__((aligned(16))) unsigned char lds_raw[];
    LAS unsigned char* lds = (LAS unsigned char*)lds_raw;
    CParams* Pk = (CParams*)__builtin_amdgcn_kernarg_segment_ptr();
    const int lo = Pk->ph_lo, hi = Pk->ph_hi;
#if !MULTI_LAUNCH
    volatile LAS unsigned* bst = (volatile LAS unsigned*)(lds + LDS_BYTES - 64);
    if (threadIdx.x < 2) bst[threadIdx.x] = 0u;
    __syncthreads();
    const XcdBarrier bar = xcd_barrier_post((unsigned*)(Pk->ws + WS_BAR), bst);
#endif
    int rep = 0;
#pragma unroll 1
    for (int ph = lo; ph < hi;) {
#if !MULTI_LAUNCH
        if (ph > lo && rep == 0 && phase_needs_sync(ph)) { if (ph == 1) cg::this_grid().sync(); else xcd_barrier(bar); }
        else if (ph > lo) __syncthreads();
#endif
        CParams* Pl = Pk; int phl = ph; asm volatile("" : "+s"(Pl), "+s"(phl));
        run_phase(*Pl, lds, phl);
#ifdef REP_ST
        { const int r = (ph - 1) % PH_PER_GROUP; if (ph > 0 && r < DEPTH * PH_PER_LAYER && ((REP_ST >> (r % PH_PER_LAYER)) & 1) && rep < REP_N) { ++rep; continue; } }
#endif
        rep = 0; ++ph;
    }
}

extern "C" void kernel_launch(void* const* d_in, const int* in_sizes, int n_in, void* d_out, int out_size, void* d_ws, size_t ws_size, hipStream_t stream) {
    static int grid = 0;
    if (grid == 0) {
        if (n_in != 26 || ws_size < WS_END || out_size != 24 * SEQ * DM) { fprintf(stderr, "kernel_launch: unexpected shapes (n_in %d, ws %zu, out %d)\n", n_in, ws_size, out_size); grid = -1; return; }
        int dev = 0, cus = 0, per_cu = 0;
        (void)hipGetDevice(&dev); (void)hipDeviceGetAttribute(&cus, hipDeviceAttributeMultiprocessorCount, dev);
        (void)hipFuncSetAttribute((const void*)mk_fwd, hipFuncAttributeMaxDynamicSharedMemorySize, LDS_BYTES);
        (void)hipOccupancyMaxActiveBlocksPerMultiprocessor(&per_cu, (const void*)mk_fwd, NTHR, LDS_BYTES);
        (void)hipGetLastError();
        grid = (per_cu >= 1 && cus == 256) ? cus : -1;
        if (grid < 0) { fprintf(stderr, "kernel_launch: occupancy query says %d blocks/CU\n", per_cu); return; }
    }
    if (grid < 0) return;
    if (hipMemsetAsync((char*)d_ws + WS_BAR, 0, XCD_BAR_WORDS * 4, stream) != hipSuccess) { fprintf(stderr, "kernel_launch: memset failed\n"); return; }
    Params p{};
    for (int i = 0; i < 26; ++i) p.in[i] = (const float*)d_in[i];
    p.out = (float*)d_out; p.ws = (unsigned char*)d_ws;
    for (int i = 0; i < 16; ++i) { const float e = (float)(2 * i) / 32.0f; const float pw = powf(10000.0f, e); p.invf[i] = 1.0f / pw; }
#if MULTI_LAUNCH
    for (int ph = 0; ph < N_PHASES; ++ph) { p.ph_lo = ph; p.ph_hi = ph + 1; hipLaunchKernelGGL(mk_fwd, dim3(grid), dim3(NTHR), LDS_BYTES, stream, p); }
#else
    p.ph_lo = 0; p.ph_hi = N_PHASES;
    void* args[] = {&p};
    hipError_t e = hipLaunchCooperativeKernel((const void*)mk_fwd, dim3(grid), dim3(NTHR), args, LDS_BYTES, stream);
    if (e != hipSuccess) fprintf(stderr, "cooperative launch failed: %s (grid %d)\n", hipGetErrorString(e), grid);
#endif
}
```

```cpp
#include <hip/hip_runtime.h>
#include <hip/hip_cooperative_groups.h>
#include <cstdio>
#include <cstdint>
#include <cmath>
namespace cg = cooperative_groups;
#ifndef MULTI_LAUNCH
#define MULTI_LAUNCH 0
#endif
__device__ __forceinline__ int tid_() { int t = threadIdx.x; asm volatile("" : "+v"(t)); return t; }
__device__ __forceinline__ int bid_() { int b = blockIdx.x; asm volatile("" : "+s"(b)); return b; }
__device__ __forceinline__ int nblk_() { int g = gridDim.x; asm volatile("" : "+s"(g)); return g; }
namespace pg8 {
#define PG8_LAS __attribute__((address_space(3)))
typedef unsigned short bf16_t;
typedef short bf16x8 __attribute__((ext_vector_type(8)));
typedef float f32x4 __attribute__((ext_vector_type(4)));
typedef unsigned u32x4 __attribute__((ext_vector_type(4)));
constexpr int BM = 256, BK = 64, HALF = 128, HTB = HALF * BK * 2  , STAGE_BYTES = 8 * HTB, NXCD = 8, WGM = 8;

__host__ __device__ __forceinline__ int lds_byte(int r, int c) { const int st = (r >> 4) * 2 + (c >> 5), rr = r & 15, cc = c & 31, ob = rr * 64 + cc * 2; return st * 1024 + (ob ^ (((ob >> 9) & 1) << 5)); }
__host__ __device__ __forceinline__ void stage_rc(int b, int& R, int& C) { const int st = b / 1024, sb = b % 1024, swz = sb ^ (((sb >> 9) & 1) << 5); R = (st >> 1) * 16 + swz / 64; C = (st & 1) * 32 + (swz % 64) / 2; }
__host__ __device__ __forceinline__ int perm32(int rho) { const int n = rho >> 4, i = rho & 15; return 8 * (i >> 2) + 4 * n + (i & 3); }

struct Unit { int pm, pn; };
struct Gemm { const bf16_t* A; const bf16_t* Bt; int M, N, K, lda, ldb; };

struct StaticOrder {
    int nM, nN, nwg, G, c;
    __host__ __device__ void init(int M, int N, int G_, int c_) { nM = M / BM; nN = N / BM; nwg = nM * nN; G = G_; c = c_; }
    __host__ __device__ bool next(int i, Unit& u) const {
        const long L = (long)i * G + c; if (L >= nwg) return false;
        int wgid = (int)L; { const int q = nwg / NXCD, r = nwg % NXCD, xcd = wgid % NXCD, off = wgid / NXCD; wgid = (xcd < r ? xcd * (q + 1) : r * (q + 1) + (xcd - r) * q) + off; }
        const int nig = WGM * nN, gid = wgid / nig, fm = gid * WGM, gsz = (nM - fm) < WGM ? (nM - fm) : WGM;
        u.pm = fm + ((wgid % nig) % gsz); u.pn = (wgid % nig) / gsz; return true;
    }
    __device__ __forceinline__ void a_ready(const Unit&) const {}
    __device__ __forceinline__ void done(const Unit&) const {}
};

template <class Epi, class Sched, bool ALIGN_EPI = false, bool SP2 = false>
__device__ __forceinline__ void gemm_phase(PG8_LAS unsigned char* lds, const Gemm g, const Sched& S, const Epi& E) {
    const int tid = tid_(), wid = __builtin_amdgcn_readfirstlane(tid >> 6), lane = tid & 63, wr = wid >> 2, wc = wid & 3, fr = lane & 15, fq = lane >> 4;
    const int K = g.K, nt = K / BK;
    unsigned voffA[2], voffB[2];
#pragma unroll
    for (int i = 0; i < 2; ++i) { int R, C; stage_rc(tid * 16 + i * 8192, R, C); const int Rb = Epi::PERM ? ((R & ~31) + perm32(R & 31)) : R;
        voffA[i] = (unsigned)(R * g.lda + C) * 2u; voffB[i] = (unsigned)(Rb * g.ldb + C) * 2u; }
    const size_t kstep = (size_t)(BK * 2);
    const size_t hsA = (size_t)HALF * g.lda * 2, hsB = (size_t)HALF * g.ldb * 2;
    const size_t tsA = 2 * hsA, tsB = 2 * hsB;
    const unsigned ldsw = (unsigned)wid * 1024u;
    const int aoff = lds_byte(wr * 64 + fr, fq * 8), boff = lds_byte(wc * 32 + fr, fq * 8);
#define PG8_SA(b, h) (((b) * 2 + (h)) * HTB)
#define PG8_SB(b, h) ((4 + (b) * 2 + (h)) * HTB)
#define PG8_STAGE(bufoff, gbase, voff) do { _Pragma("unroll") for (int _i = 0; _i < 2; ++_i) \
        __builtin_amdgcn_global_load_lds((const unsigned*)((const char*)(gbase) + (voff)[_i]), (PG8_LAS unsigned*)(lds + (bufoff) + ldsw + _i * 8192), 16, 0, 0); } while (0)
#define PG8_LDA(dst, b, h) do { _Pragma("unroll") for (int m = 0; m < 4; ++m) _Pragma("unroll") for (int k = 0; k < 2; ++k) dst[m][k] = *(const PG8_LAS bf16x8*)(lds + PG8_SA(b, h) + aoff + m * 2048 + k * 1024); } while (0)
#define PG8_LDB(dst, b, h) do { _Pragma("unroll") for (int n = 0; n < 2; ++n) _Pragma("unroll") for (int k = 0; k < 2; ++k) dst[n][k] = *(const PG8_LAS bf16x8*)(lds + PG8_SB(b, h) + boff + n * 2048 + k * 1024); } while (0)
#define PG8_MMA(ai, bj, At, Bt) do { __builtin_amdgcn_s_setprio(1); _Pragma("unroll") for (int m = 0; m < 4; ++m) _Pragma("unroll") for (int n = 0; n < 2; ++n) _Pragma("unroll") for (int k = 0; k < 2; ++k) \
        acc[ai][bj][m][n] = __builtin_amdgcn_mfma_f32_16x16x32_bf16(Bt[n][k], At[m][k], acc[ai][bj][m][n], 0, 0, 0); __builtin_amdgcn_s_setprio(0); } while (0)
#define PG8_WAIT_V(n) asm volatile("s_waitcnt vmcnt(" #n ")" ::: "memory")
#define PG8_WAIT_L(n) asm volatile("s_waitcnt lgkmcnt(" #n ")" ::: "memory")
#define PG8_BAR __builtin_amdgcn_s_barrier()
#define PG8_SCHED __builtin_amdgcn_sched_barrier(0)
    Unit cur, nxt; int ui = 0;
    if (!S.next(0, cur)) return;
    f32x4 acc[2][2][4][2];
#pragma unroll
    for (int a = 0; a < 2; ++a)
#pragma unroll
        for (int b = 0; b < 2; ++b)
#pragma unroll
            for (int m = 0; m < 4; ++m)
#pragma unroll
                for (int n = 0; n < 2; ++n) acc[a][b][m][n] = (f32x4){0.f, 0.f, 0.f, 0.f};
    bf16x8 At[4][2], B0[2][2], B1[2][2];
    const char* cA = (const char*)g.A + (size_t)cur.pm * tsA; const char* cB = (const char*)g.Bt + (size_t)cur.pn * tsB;
    S.a_ready(cur);
    if constexpr (SP2) {
        PG8_STAGE(PG8_SB(0, 0), cB, voffB); PG8_STAGE(PG8_SB(0, 1), cB + hsB, voffB); PG8_STAGE(PG8_SA(0, 0), cA, voffA); PG8_STAGE(PG8_SA(0, 1), cA + hsA, voffA);
        if (wr == 1) PG8_BAR;
        PG8_WAIT_V(2); PG8_BAR;
        PG8_STAGE(PG8_SB(1, 0), cB + kstep, voffB); PG8_STAGE(PG8_SA(1, 0), cA + kstep, voffA); PG8_STAGE(PG8_SB(1, 1), cB + hsB + kstep, voffB);
        PG8_WAIT_V(6); PG8_BAR;
    } else {
        PG8_STAGE(PG8_SB(0, 0), cB, voffB); PG8_STAGE(PG8_SA(0, 0), cA, voffA); PG8_STAGE(PG8_SB(0, 1), cB + hsB, voffB); PG8_STAGE(PG8_SA(0, 1), cA + hsA, voffA);
        if (wr == 1) PG8_BAR;
        PG8_WAIT_V(4); PG8_BAR;
        PG8_STAGE(PG8_SB(1, 0), cB + kstep, voffB); PG8_STAGE(PG8_SA(1, 0), cA + kstep, voffA); PG8_STAGE(PG8_SB(1, 1), cB + hsB + kstep, voffB);
        PG8_WAIT_V(6); PG8_BAR;
    }
    for (;;) {
        const bool has_next = S.next(ui + 1, nxt);
        const char* nA = has_next ? (const char*)g.A + (size_t)nxt.pm * tsA : cA; const char* nB = has_next ? (const char*)g.Bt + (size_t)nxt.pn * tsB : cB;
        for (int t = 0; t < nt; t += 2) {
            const bool last = (t == nt - 2);
            const char* a1 = cA + (size_t)(t + 1) * kstep;
            const char* a2 = last ? nA : cA + (size_t)(t + 2) * kstep; const char* b2 = last ? nB : cB + (size_t)(t + 2) * kstep;
            const char* a3 = a2 + kstep; const char* b3 = b2 + kstep;
            if (last && has_next) S.a_ready(nxt);
            if constexpr (SP2) {
            PG8_LDB(B0, 0, 0); PG8_LDB(B1, 0, 1); PG8_SCHED; PG8_LDA(At, 0, 0); PG8_STAGE(PG8_SA(1, 1), a1 + hsA, voffA);
            PG8_WAIT_V(8); PG8_WAIT_L(0); PG8_BAR; PG8_MMA(0, 0, At, B0); PG8_MMA(0, 1, At, B1); PG8_BAR; PG8_SCHED;
            PG8_LDA(At, 0, 1); PG8_STAGE(PG8_SB(0, 0), b2, voffB); PG8_STAGE(PG8_SB(0, 1), b2 + hsB, voffB); PG8_STAGE(PG8_SA(0, 0), a2, voffA);
            PG8_WAIT_V(8); PG8_WAIT_L(0); PG8_BAR; PG8_MMA(1, 0, At, B0); PG8_MMA(1, 1, At, B1); PG8_BAR; PG8_SCHED;
            PG8_LDB(B0, 1, 0); PG8_LDB(B1, 1, 1); PG8_SCHED; PG8_LDA(At, 1, 0); PG8_STAGE(PG8_SA(0, 1), a2 + hsA, voffA);
            PG8_WAIT_V(8); PG8_WAIT_L(0); PG8_BAR; PG8_MMA(0, 0, At, B0); PG8_MMA(0, 1, At, B1); PG8_BAR; PG8_SCHED;
            PG8_LDA(At, 1, 1); PG8_STAGE(PG8_SB(1, 0), b3, voffB); PG8_STAGE(PG8_SB(1, 1), b3 + hsB, voffB); PG8_STAGE(PG8_SA(1, 0), a3, voffA);
            PG8_WAIT_V(8); PG8_WAIT_L(0); PG8_BAR; PG8_MMA(1, 0, At, B0); PG8_MMA(1, 1, At, B1); PG8_BAR; PG8_SCHED;
            } else {
            PG8_LDB(B0, 0, 0); PG8_SCHED; PG8_LDA(At, 0, 0); PG8_STAGE(PG8_SA(1, 1), a1 + hsA, voffA);
            PG8_WAIT_L(8); PG8_BAR; PG8_WAIT_L(0); PG8_MMA(0, 0, At, B0); PG8_BAR; PG8_SCHED;
            PG8_LDB(B1, 0, 1); PG8_STAGE(PG8_SB(0, 0), b2, voffB);
            PG8_BAR; PG8_WAIT_L(0); PG8_MMA(0, 1, At, B1); PG8_BAR;
            PG8_LDA(At, 0, 1); PG8_STAGE(PG8_SA(0, 0), a2, voffA);
            PG8_BAR; PG8_WAIT_L(0); PG8_MMA(1, 0, At, B0); PG8_BAR; PG8_SCHED;
            PG8_STAGE(PG8_SB(0, 1), b2 + hsB, voffB);
            PG8_WAIT_V(6); PG8_BAR; PG8_MMA(1, 1, At, B1); PG8_BAR;
            PG8_LDB(B0, 1, 0); PG8_SCHED; PG8_LDA(At, 1, 0); PG8_STAGE(PG8_SA(0, 1), a2 + hsA, voffA);
            PG8_WAIT_L(8); PG8_BAR; PG8_WAIT_L(0); PG8_MMA(0, 0, At, B0); PG8_BAR; PG8_SCHED;
            PG8_LDB(B1, 1, 1); PG8_STAGE(PG8_SB(1, 0), b3, voffB);
            PG8_BAR; PG8_WAIT_L(0); PG8_MMA(0, 1, At, B1); PG8_BAR;
            PG8_LDA(At, 1, 1); PG8_STAGE(PG8_SA(1, 0), a3, voffA);
            PG8_BAR; PG8_WAIT_L(0); PG8_MMA(1, 0, At, B0); PG8_BAR; PG8_SCHED;
            PG8_STAGE(PG8_SB(1, 1), b3 + hsB, voffB);
            PG8_WAIT_V(6); PG8_BAR; PG8_MMA(1, 1, At, B1); PG8_BAR;
            }
        }
        if constexpr (ALIGN_EPI) { if (wr == 0) PG8_BAR; }
        if constexpr (!Epi::AFTER_DRAIN) { E(acc, cur, wr, wc, fr, fq); S.done(cur); }
        if (!has_next) break;
#pragma unroll
        for (int a = 0; a < 2; ++a)
#pragma unroll
            for (int b = 0; b < 2; ++b)
#pragma unroll
                for (int m = 0; m < 4; ++m)
#pragma unroll
                    for (int n = 0; n < 2; ++n) acc[a][b][m][n] = (f32x4){0.f, 0.f, 0.f, 0.f};
        cur = nxt; cA = nA; cB = nB; ++ui;
        if constexpr (ALIGN_EPI) { if (wr == 1) PG8_BAR; }
    }
    PG8_WAIT_V(0);
    if constexpr (!ALIGN_EPI) { if (wr == 0) PG8_BAR; }
    PG8_BAR;
    if constexpr (Epi::AFTER_DRAIN) { E.fused(acc, cur, wr, wc, fr, fq, lds, wid, lane); S.done(cur); }
#undef PG8_SA
#undef PG8_SB
#undef PG8_STAGE
#undef PG8_LDA
#undef PG8_LDB
#undef PG8_MMA
#undef PG8_WAIT_V
#undef PG8_WAIT_L
#undef PG8_BAR
#undef PG8_SCHED
}
}

#define LAS __attribute__((address_space(3)))
typedef unsigned short bf16_t;
typedef _Float16 f16;
typedef _Float16 f16x8 __attribute__((ext_vector_type(8)));
typedef float f32x4 __attribute__((ext_vector_type(4)));
typedef float f32x2 __attribute__((ext_vector_type(2)));
typedef float f32x16 __attribute__((ext_vector_type(16)));
typedef unsigned u32x4 __attribute__((ext_vector_type(4)));
typedef unsigned u32x2 __attribute__((ext_vector_type(2)));
typedef short bf16x8 __attribute__((ext_vector_type(8)));
typedef __bf16 bf16x2_t __attribute__((ext_vector_type(2)));

constexpr int DM = 1024, SEQ = 4096, GSEQ = 8, TG = GSEQ * SEQ, NGROUP = 3, DEPTH = 2;
constexpr int NIN = 4416, NINP = 4608, NP2 = 2560, DFF = 2816, NGU = 5632;
constexpr int NWAVES = 8, NTHR = 512;
constexpr float QSCALE = 0.10206207261596577f * 1.4426950408889634f;
constexpr size_t MiB = 1u << 20;
constexpr size_t WS_ROPE = 0;
constexpr size_t WS_RSTD = 512 * 1024;
constexpr size_t WS_BAR = 768 * 1024;
constexpr size_t WS_BS = 1 * MiB;
constexpr size_t WS_W = 2 * MiB;
constexpr size_t WL_IN = 0, WL_DEC = 9 * MiB, WL_ICL = WL_DEC + 256 * 1024, WL_GATE = WL_ICL + 256 * 1024, WL_UQ = WL_GATE + 256 * 1024,
                 WL_UKV = WL_UQ + 384 * 1024, WL_OA = WL_UKV + 256 * 1024, WL_OB = WL_OA + MiB, WL_OUT = WL_OB + MiB, WL_GU = WL_OUT + 2 * MiB,
                 WL_DOWN = WL_GU + 11 * MiB, WL_SIZE = 31 * MiB;
static_assert(WL_DOWN + 5632 * 1024 <= WL_SIZE, "weights");
constexpr size_t WS_H = 64 * MiB;
constexpr size_t WS_P2 = 128 * MiB;
constexpr size_t WS_GATES = WS_P2 + 160 * MiB;
constexpr size_t WS_SC = WS_GATES + 128 * MiB;
constexpr size_t WS_SCD = WS_SC + 96 * MiB;
constexpr size_t WS_V16 = WS_SC + 320 * MiB;
constexpr size_t WS_LIN = WS_V16 + 32 * MiB;
constexpr size_t WS_G = WS_LIN + 32 * MiB;
constexpr size_t WS_Q = WS_G + 32 * MiB;
constexpr size_t WS_KF = WS_Q + 48 * MiB;
constexpr size_t WS_VT = WS_KF + 48 * MiB;
constexpr size_t WS_OATT = WS_VT + 32 * MiB;
constexpr size_t WS_END = WS_OATT + 32 * MiB;
static_assert(WS_END <= 1024 * MiB, "workspace map exceeds 1 GiB");
constexpr int LDS_BYTES = 136 * 1024;

struct Params { const float* in[26]; float* out; unsigned char* ws; float invf[16]; int ph_lo, ph_hi; };
typedef const __attribute__((address_space(4))) Params CParams;

__device__ __forceinline__ unsigned cvtpk(float lo, float hi) { f32x2 v = {lo, hi}; bf16x2_t b = __builtin_convertvector(v, bf16x2_t); return __builtin_bit_cast(unsigned, b); }
__device__ __forceinline__ float bflo(unsigned u) { return __uint_as_float(u << 16); }
__device__ __forceinline__ float bfhi(unsigned u) { return __uint_as_float(u & 0xffff0000u); }
__device__ __forceinline__ void unpack8(u32x4 w, float* v) { v[0] = bflo(w.x); v[1] = bfhi(w.x); v[2] = bflo(w.y); v[3] = bfhi(w.y); v[4] = bflo(w.z); v[5] = bfhi(w.z); v[6] = bflo(w.w); v[7] = bfhi(w.w); }
__device__ __forceinline__ u32x4 pack8(const float* v) { u32x4 w; w.x = cvtpk(v[0], v[1]); w.y = cvtpk(v[2], v[3]); w.z = cvtpk(v[4], v[5]); w.w = cvtpk(v[6], v[7]); return w; }
__device__ __forceinline__ float sigmoidf_(float x) { return __builtin_amdgcn_rcpf(1.0f + __builtin_amdgcn_exp2f(-1.4426950408889634f * x)); }
#define DPP_F(x, ctrl) __builtin_bit_cast(float, __builtin_amdgcn_update_dpp(0, __builtin_bit_cast(int, (x)), (ctrl), 0xF, 0xF, true))
__device__ __forceinline__ float red8(float x) { x += DPP_F(x, 0xB1); x += DPP_F(x, 0x4E); x += DPP_F(x, 0x141); return x; }
__device__ __forceinline__ float red16(float x) { x = red8(x); x += DPP_F(x, 0x140); return x; }
__device__ __forceinline__ float sum8(float v) { return red8(v); }
__device__ __forceinline__ float wave_sum(float v) { const int t = __builtin_bit_cast(int, red16(v));
    return (__builtin_bit_cast(float, __builtin_amdgcn_readlane(t, 0)) + __builtin_bit_cast(float, __builtin_amdgcn_readlane(t, 16))) + (__builtin_bit_cast(float, __builtin_amdgcn_readlane(t, 32)) + __builtin_bit_cast(float, __builtin_amdgcn_readlane(t, 48))); }

#define EPI_ARGS const pg8::f32x4 (&acc)[2][2][4][2], const pg8::Unit& u, int wr, int wc, int fr, int fq
#define FOR_ROWS for (int ai = 0; ai < 2; ++ai) _Pragma("unroll") for (int m = 0; m < 4; ++m)
struct EpiIn {
    static constexpr bool PERM = true, AFTER_DRAIN = false;
    bf16_t* gates; bf16_t* p2;
    __device__ __forceinline__ void operator()(EPI_ARGS) const {
        const bool isg = u.pn < 8; bf16_t* base = isg ? gates : p2; const int ld = isg ? 2048 : NP2; const int c0 = (isg ? u.pn : u.pn - 8) * 256 + wc * 32 + 8 * fq;
#pragma unroll
        FOR_ROWS { const size_t row = (size_t)u.pm * 256 + ai * 128 + wr * 64 + m * 16 + fr;
#pragma unroll
            for (int bj = 0; bj < 2; ++bj) { float v[8];
#pragma unroll
                for (int i = 0; i < 4; ++i) { v[i] = acc[ai][bj][m][0][i]; v[4 + i] = acc[ai][bj][m][1][i]; }
                if (isg) {
#pragma unroll
                    for (int i = 0; i < 8; ++i) v[i] = sigmoidf_(v[i]); }
                *(u32x4*)(base + row * ld + c0 + bj * 128) = pack8(v); } }
    }
};
struct EpiDecay {
    static constexpr bool PERM = true, AFTER_DRAIN = false;
    f16* sc; const float* w0;
    __device__ __forceinline__ void operator()(EPI_ARGS) const {
        const int dir = u.pn >> 1;
#pragma unroll
        for (int bj = 0; bj < 2; ++bj) { const int c = (u.pn & 1) * 256 + bj * 128 + wc * 32 + 8 * fq; const int head = c >> 6, d = c & 63;
            float b0[8];
#pragma unroll
            for (int i = 0; i < 8; ++i) b0[i] = w0[dir * 512 + c + i];
#pragma unroll
            FOR_ROWS { const size_t row = (size_t)u.pm * 256 + ai * 128 + wr * 64 + m * 16 + fr; f16x8 o;
#pragma unroll
                for (int i = 0; i < 8; ++i) { const float z = b0[i] + acc[ai][bj][m][i >> 2][i & 3]; const float y = -z;
                    const float sp = fmaxf(y, 0.f) + __logf(1.0f + __expf(-fabsf(y))); o[i] = (f16)__expf(-__expf(-sp - 0.5f)); }
                *(f16x8*)(sc + (((size_t)dir * TG + row) * 8 + head) * 192 + d) = o; asm volatile("" ::: "memory"); } }
    }
};
struct EpiIclr {
    static constexpr bool PERM = true, AFTER_DRAIN = false;
    const f16* scs; f16* sc; const float* a0; const float* ka;
    __device__ __forceinline__ void operator()(EPI_ARGS) const {
        const int dir = u.pn >> 1;
#pragma unroll
        for (int bj = 0; bj < 2; ++bj) { const int c = (u.pn & 1) * 256 + bj * 128 + wc * 32 + 8 * fq; const int head = c >> 6, d = c & 63;
            float b0[8], kav[8];
#pragma unroll
            for (int i = 0; i < 8; ++i) { b0[i] = a0[dir * 512 + c + i]; kav[i] = ka[c + i]; }
#pragma unroll
            FOR_ROWS { const size_t row = (size_t)u.pm * 256 + ai * 128 + wr * 64 + m * 16 + fr;
                f16* p = sc + (((size_t)dir * TG + row) * 8 + head) * 192 + d; const f16* ps = scs + ((size_t)row * 8 + head) * 192 + d;
                const f16x8 kr = *(const f16x8*)(ps + 64), kk = *(const f16x8*)(ps + 128); f16x8 ko, bo;
#pragma unroll
                for (int i = 0; i < 8; ++i) { const float a = sigmoidf_(b0[i] + acc[ai][bj][m][i >> 2][i & 3]);
                    ko[i] = (f16)((float)kr[i] * (1.0f + (a - 1.0f) * kav[i])); bo[i] = (f16)(-(float)kk[i] * a); }
                *(f16x8*)(p + 64) = ko; *(f16x8*)(p + 128) = bo; asm volatile("" ::: "memory"); } }
    }
};
struct EpiPlain {
    static constexpr bool PERM = true, AFTER_DRAIN = false;
    bf16_t* O; int ld;
    __device__ __forceinline__ void operator()(EPI_ARGS) const {
        const int c0 = u.pn * 256 + wc * 32 + 8 * fq;
#pragma unroll
        FOR_ROWS { const size_t row = (size_t)u.pm * 256 + ai * 128 + wr * 64 + m * 16 + fr;
#pragma unroll
            for (int bj = 0; bj < 2; ++bj) { float v[8];
#pragma unroll
                for (int i = 0; i < 4; ++i) { v[i] = acc[ai][bj][m][0][i]; v[4 + i] = acc[ai][bj][m][1][i]; }
                *(u32x4*)(O + row * ld + c0 + bj * 128) = pack8(v); } }
    }
};
struct EpiQ {
    static constexpr bool PERM = false, AFTER_DRAIN = false;
    bf16_t* Q; const float* rstd; const float* cs; const float* sn;
    __device__ __forceinline__ void operator()(EPI_ARGS) const {
#pragma unroll
        FOR_ROWS { const int row = u.pm * 256 + ai * 128 + wr * 64 + m * 16 + fr; const float rs = rstd[row] * QSCALE; const int t = row & (SEQ - 1);
            const f32x4 c4 = *(const f32x4*)(cs + t * 16 + 4 * fq), s4 = *(const f32x4*)(sn + t * 16 + 4 * fq);
#pragma unroll
            for (int bj = 0; bj < 2; ++bj) { const int cb = u.pn * 256 + bj * 128 + wc * 32; const bool rope = ((cb >> 5) % 3) == 2;
                pg8::f32x4 x1 = acc[ai][bj][m][0] * rs, x2 = acc[ai][bj][m][1] * rs;
                if (rope) { const pg8::f32x4 y1 = x1 * c4 - x2 * s4, y2 = x2 * c4 + x1 * s4; x1 = y1; x2 = y2; }
                u32x2 w1, w2; w1.x = cvtpk(x1[0], x1[1]); w1.y = cvtpk(x1[2], x1[3]); w2.x = cvtpk(x2[0], x2[1]); w2.y = cvtpk(x2[2], x2[3]);
                *(u32x2*)(Q + (size_t)row * 768 + cb + 4 * fq) = w1; *(u32x2*)(Q + (size_t)row * 768 + cb + 16 + 4 * fq) = w2; } asm volatile("" ::: "memory"); }
    }
};
struct EpiKV {
    static constexpr bool PERM = true, AFTER_DRAIN = false;
    bf16_t* KF; bf16_t* VT; const float* rstd;
    __device__ __forceinline__ void operator()(EPI_ARGS) const {
#pragma unroll
        FOR_ROWS { const int row = u.pm * 256 + ai * 128 + wr * 64 + m * 16 + fr; const float rs = rstd[row]; const int s = row >> 12, t = row & (SEQ - 1);
#pragma unroll
            for (int bj = 0; bj < 2; ++bj) { const int c = u.pn * 256 + bj * 128 + wc * 32 + 8 * fq; const int head = c >> 7, w = c & 127; float v[8];
#pragma unroll
                for (int i = 0; i < 4; ++i) { v[i] = acc[ai][bj][m][0][i] * rs; v[4 + i] = acc[ai][bj][m][1][i] * rs; }
                if (w < 64) *(u32x4*)(KF + (size_t)row * 768 + head * 96 + w) = pack8(v);
                else { const u32x4 pk = pack8(v); bf16_t* vp = VT + ((size_t)(s * 8 + head) * 64 + (w - 64)) * SEQ + t;
                    vp[0] = (bf16_t)pk.x; vp[SEQ] = (bf16_t)(pk.x >> 16); vp[2 * SEQ] = (bf16_t)pk.y; vp[3 * SEQ] = (bf16_t)(pk.y >> 16);
                    vp[4 * SEQ] = (bf16_t)pk.z; vp[5 * SEQ] = (bf16_t)(pk.z >> 16); vp[6 * SEQ] = (bf16_t)pk.w; vp[7 * SEQ] = (bf16_t)(pk.w >> 16); } } asm volatile("" ::: "memory"); }
    }
};
template <int SECOND> struct EpiMix {
    static constexpr bool PERM = true, AFTER_DRAIN = false;
    bf16_t* mix; const bf16_t* gates;
    __device__ __forceinline__ void operator()(EPI_ARGS) const {
        const int c0 = u.pn * 256 + wc * 32 + 8 * fq;
#pragma unroll
        FOR_ROWS { const size_t row = (size_t)u.pm * 256 + ai * 128 + wr * 64 + m * 16 + fr;
#pragma unroll
            for (int bj = 0; bj < 2; ++bj) { float v[8], g[8];
                unpack8(*(const u32x4*)(gates + row * 2048 + SECOND * 1024 + c0 + bj * 128), g);
#pragma unroll
                for (int i = 0; i < 4; ++i) { v[i] = acc[ai][bj][m][0][i] * g[i]; v[4 + i] = acc[ai][bj][m][1][i] * g[4 + i]; }
                u32x4* dst = (u32x4*)(mix + row * 1024 + c0 + bj * 128);
                if (SECOND) { float o[8]; unpack8(*dst, o);
#pragma unroll
                    for (int i = 0; i < 8; ++i) v[i] += o[i]; }
                *dst = pack8(v); asm volatile("" ::: "memory"); } }
    }
};
struct EpiRes {
    static constexpr bool PERM = false, AFTER_DRAIN = false;
    const float* src; float* dst;
    __device__ __forceinline__ void operator()(EPI_ARGS) const {
        const int c0 = u.pn * 256 + wc * 32 + 4 * fq;
#pragma unroll
        FOR_ROWS { const size_t off = ((size_t)u.pm * 256 + ai * 128 + wr * 64 + m * 16 + fr) * 1024 + c0;
#pragma unroll
            for (int bj = 0; bj < 2; ++bj)
#pragma unroll
                for (int n = 0; n < 2; ++n) { const pg8::f32x4 b = *(const pg8::f32x4*)(src + off + bj * 128 + n * 16); *(pg8::f32x4*)(dst + off + bj * 128 + n * 16) = b + acc[ai][bj][m][n]; } asm volatile("" ::: "memory"); }
    }
};
struct EpiGU {
    static constexpr bool PERM = false, AFTER_DRAIN = false;
    bf16_t* hid;
    __device__ __forceinline__ void operator()(EPI_ARGS) const {
#pragma unroll
        FOR_ROWS { const size_t row = (size_t)u.pm * 256 + ai * 128 + wr * 64 + m * 16 + fr;
#pragma unroll
            for (int bj = 0; bj < 2; ++bj) { const int grp = (u.pn * 256 + bj * 128 + wc * 32) >> 5; const pg8::f32x4 g = acc[ai][bj][m][0], up = acc[ai][bj][m][1]; float o[4];
#pragma unroll
                for (int i = 0; i < 4; ++i) o[i] = g[i] * sigmoidf_(g[i]) * up[i];
                u32x2 w; w.x = cvtpk(o[0], o[1]); w.y = cvtpk(o[2], o[3]); *(u32x2*)(hid + row * DFF + grp * 16 + 4 * fq) = w; } }
    }
};
#define XB_TMO      128
#define XB_XCNT(j)  (256  + 64 * (j))
#define XB_XSUB(j)  (1280 + 64 * (j))
#define XB_XGEN(j)  (2304 + 64 * (j))
#define XB_TOP      3328
#define XB_TOPGEN   3392
#define XCD_BAR_WORDS 3456
#define XB_SPIN_CAP (1u << 18)

__device__ __forceinline__ unsigned xb_ld(unsigned* p)              { return __hip_atomic_load(p, __ATOMIC_RELAXED, __HIP_MEMORY_SCOPE_AGENT); }
__device__ __forceinline__ unsigned xb_add(unsigned* p, unsigned v) { return __hip_atomic_fetch_add(p, v, __ATOMIC_RELAXED, __HIP_MEMORY_SCOPE_AGENT); }
__device__ __forceinline__ unsigned xb_xcc_id() { return (unsigned)__builtin_amdgcn_s_getreg((3 << 11) | 20) & 0xFu; }
#define XB_SPIN(cond, bar) do { unsigned _sp = 0; while (cond) { __builtin_amdgcn_s_sleep(1); \
    if ((++_sp & 255u) == 0u) { if (xb_ld(&(bar)[XB_TMO])) break; if (_sp > XB_SPIN_CAP) { atomicAdd(&(bar)[XB_TMO], 1u); break; } } } } while (0)

struct XcdBarrier {
    unsigned* bar; unsigned x;
    volatile LAS unsigned* st;
};

__device__ __forceinline__ XcdBarrier xcd_barrier_post(unsigned* bar, volatile LAS unsigned* st) {
    XcdBarrier b; b.bar = bar; b.x = xb_xcc_id(); b.st = st;
    if (threadIdx.x == 0) (void)xb_add(&bar[XB_XCNT(b.x)], 1u);
    return b;
}
__device__ __forceinline__ void xcd_barrier_complete(unsigned* bar, unsigned x, unsigned& nloc, unsigned& nx) {
    const unsigned G = gridDim.x * gridDim.y * gridDim.z;
    unsigned sum, cnt, mine, sp = 0u;
    for (;;) {
        sum = 0u; cnt = 0u; mine = 0u;
#pragma unroll
        for (unsigned j = 0; j < 16; ++j) { const unsigned c = xb_ld(&bar[XB_XCNT(j)]); sum += c; cnt += (c > 0u) ? 1u : 0u; mine = (j == x) ? c : mine; }
        if (sum == G) break;
        __builtin_amdgcn_s_sleep(1);
        if ((++sp & 255u) == 0u) { if (xb_ld(&bar[XB_TMO])) break; if (sp > XB_SPIN_CAP) { atomicAdd(&bar[XB_TMO], 1u); break; } }
    }
    nloc = mine > 0u ? mine : 1u; nx = cnt > 0u ? cnt : 1u;
}

__device__ __forceinline__ void xcd_barrier(const XcdBarrier& b) {
    asm volatile("s_waitcnt vmcnt(0)" ::: "memory");
    __syncthreads();
    if (threadIdx.x == 0) {
        unsigned* bar = b.bar;
        __builtin_amdgcn_s_waitcnt(0);
        unsigned nloc = b.st[0], nx = b.st[1];
        if (nloc == 0u) { xcd_barrier_complete(bar, b.x, nloc, nx); b.st[0] = nloc; b.st[1] = nx; }
        const unsigned old = xb_add(&bar[XB_XSUB(b.x)], 1u);
        const unsigned gen = old / nloc;
        if (old + 1u == (gen + 1u) * nloc) {
            __builtin_amdgcn_fence(__ATOMIC_RELEASE, "agent");
            asm volatile("s_waitcnt vmcnt(0)" ::: "memory");
            const unsigned og = xb_add(&bar[XB_TOP], 1u);
            const unsigned tg = og / nx;
            if (og + 1u == (tg + 1u) * nx) xb_add(&bar[XB_TOPGEN], 1u);
            else XB_SPIN(xb_ld(&bar[XB_TOPGEN]) == tg, bar);
            __builtin_amdgcn_fence(__ATOMIC_ACQUIRE, "agent");
            xb_add(&bar[XB_XGEN(b.x)], 1u);
            asm volatile("s_waitcnt vmcnt(0)" ::: "memory");
        } else {
            XB_SPIN(xb_ld(&bar[XB_XGEN(b.x)]) == gen, bar);
            __builtin_amdgcn_fence(__ATOMIC_ACQUIRE, "agent");
            asm volatile("s_waitcnt vmcnt(0)" ::: "memory");
        }
    }
    __syncthreads();
}

template <class F> __device__ __forceinline__ void prep_mat(bf16_t* dst, int N, int K, F f) {
    const int kc = K >> 3, total = N * kc; const int gsz = nblk_() * NTHR;
    for (int i = bid_() * NTHR + tid_(); i < total; i += gsz) { const int n = i % N, k0 = (i / N) << 3; float v[8];
#pragma unroll
        for (int j = 0; j < 8; ++j) v[j] = f(n, k0 + j);
        *(u32x4*)(dst + (size_t)n * K + k0) = pack8(v); }
}
__device__ __forceinline__ void phase_weights(CParams& P) {
    { float* cs = (float*)(P.ws + WS_ROPE); float* sn = cs + SEQ * 16; const int gsz = nblk_() * NTHR;
      for (int i = bid_() * NTHR + tid_(); i < SEQ * 16; i += gsz) { const int pos = i >> 4, j = i & 15;
          const double turns = (double)((float)pos * P.invf[j]) * 0.15915494309189535; const float fr = (float)(turns - floor(turns));
          cs[i] = __builtin_amdgcn_cosf(fr); sn[i] = __builtin_amdgcn_sinf(fr); } }
    for (int l = 0; l < DEPTH; ++l) { unsigned char* wb = P.ws + WS_W + (size_t)l * WL_SIZE;
        { const float* w = P.in[3] + (size_t)l * DM * NIN; prep_mat((bf16_t*)(wb + WL_IN), NINP, 1024, [=](int n, int k) { return n < NIN ? w[(size_t)k * NIN + n] : 0.f; }); }
        { const float* w = P.in[5] + (size_t)l * 2 * 64 * 512; prep_mat((bf16_t*)(wb + WL_DEC), 1024, 128, [=](int n, int k) { const int dir = n >> 9; return (k >> 6) == dir ? w[(size_t)dir * 64 * 512 + (k & 63) * 512 + (n & 511)] : 0.f; }); }
        { const float* w = P.in[7] + (size_t)l * 2 * 64 * 512; prep_mat((bf16_t*)(wb + WL_ICL), 1024, 128, [=](int n, int k) { const int dir = n >> 9; return (k >> 6) == dir ? w[(size_t)dir * 64 * 512 + (k & 63) * 512 + (n & 511)] : 0.f; }); }
        { const float* w = P.in[9] + (size_t)l * 160 * 512; prep_mat((bf16_t*)(wb + WL_GATE), 512, 256, [=](int n, int k) { return k < 160 ? w[(size_t)k * 512 + n] : 0.f; }); }
        { const float* w = P.in[17] + (size_t)l * 256 * 768; const float* g = P.in[16] + l * 256; prep_mat((bf16_t*)(wb + WL_UQ), 768, 256, [=](int n, int k) { return g[k] * w[(size_t)k * 768 + n]; }); }
        { const float* w = P.in[19] + (size_t)l * 128 * 1024; const float* g = P.in[18] + l * 128; prep_mat((bf16_t*)(wb + WL_UKV), 1024, 128, [=](int n, int k) { return g[k] * w[(size_t)k * 1024 + n]; }); }
        { const float* w = P.in[15] + (size_t)l * 512 * 1024; prep_mat((bf16_t*)(wb + WL_OA), 1024, 512, [=](int n, int k) { return w[(size_t)k * 1024 + n]; }); }
        { const float* w = P.in[20] + (size_t)l * 512 * 1024; prep_mat((bf16_t*)(wb + WL_OB), 1024, 512, [=](int n, int k) { return w[(size_t)k * 1024 + n]; }); }
        { const float* w = P.in[21] + (size_t)l * 1024 * 1024; prep_mat((bf16_t*)(wb + WL_OUT), 1024, 1024, [=](int n, int k) { return w[(size_t)k * 1024 + n]; }); }
        { const float* w = P.in[23] + (size_t)l * 1024 * NGU; prep_mat((bf16_t*)(wb + WL_GU), NGU, 1024, [=](int n, int k) { const int j = (n >> 5) * 16 + (n & 15); const int col = (n & 16) ? DFF + j : j; return w[(size_t)k * NGU + col]; }); }
        { const float* w = P.in[24] + (size_t)l * DFF * 1024; prep_mat((bf16_t*)(wb + WL_DOWN), 1024, DFF, [=](int n, int k) { return w[(size_t)k * 1024 + n]; }); }
    }
}
__device__ __forceinline__ void phase_norm(const float* x, const float* g, bf16_t* H) {
    const int tid = tid_(), lane = tid & 63, gw = bid_() * NWAVES + (tid >> 6), nw = nblk_() * NWAVES;
    f32x4 gv[4];
#pragma unroll
    for (int j = 0; j < 4; ++j) gv[j] = *((const f32x4*)g + lane + 64 * j);
    f32x4 nv[4], nu[4];
    { const f32x4* xr = (const f32x4*)(x + (size_t)gw * DM) + lane; const f32x4* xq = (const f32x4*)(x + (size_t)(gw + nw) * DM) + lane;
#pragma unroll
      for (int j = 0; j < 4; ++j) { nv[j] = xr[64 * j]; nu[j] = xq[64 * j]; } }
#pragma unroll 1
    for (int r = gw; r < TG; r += 2 * nw) { const int r2 = r + nw;
        f32x4 v[4], u[4]; float s = 0.f, s2 = 0.f;
#pragma unroll
        for (int j = 0; j < 4; ++j) { v[j] = nv[j]; u[j] = nu[j]; }
        if (r + 2 * nw < TG) { const f32x4* xr = (const f32x4*)(x + (size_t)(r + 2 * nw) * DM) + lane; const f32x4* xq = (const f32x4*)(x + (size_t)(r2 + 2 * nw) * DM) + lane;
#pragma unroll
            for (int j = 0; j < 4; ++j) { nv[j] = xr[64 * j]; nu[j] = xq[64 * j]; } }
#pragma unroll
        for (int j = 0; j < 4; ++j) { s += (v[j].x * v[j].x + v[j].y * v[j].y) + (v[j].z * v[j].z + v[j].w * v[j].w); s2 += (u[j].x * u[j].x + u[j].y * u[j].y) + (u[j].z * u[j].z + u[j].w * u[j].w); }
        const float rstd = __builtin_amdgcn_rsqf(wave_sum(s) * (1.0f / DM) + 1e-6f), rstd2 = __builtin_amdgcn_rsqf(wave_sum(s2) * (1.0f / DM) + 1e-6f);
        u32x2* o = (u32x2*)(H + (size_t)r * DM) + lane; u32x2* o2 = (u32x2*)(H + (size_t)r2 * DM) + lane;
#pragma unroll
        for (int j = 0; j < 4; ++j) { const f32x4 y = v[j] * rstd * gv[j], z = u[j] * rstd2 * gv[j]; u32x2 w, w2; w.x = cvtpk(y.x, y.y); w.y = cvtpk(y.z, y.w); w2.x = cvtpk(z.x, z.y); w2.y = cvtpk(z.z, z.w); o[64 * j] = w; o2[64 * j] = w2; } }
}
__device__ __forceinline__ void phase_final_norm(float* x, const float* g) {
    const int tid = tid_(), lane = tid & 63, gw = bid_() * NWAVES + (tid >> 6), nw = nblk_() * NWAVES;
    f32x4 gv[4];
#pragma unroll
    for (int j = 0; j < 4; ++j) gv[j] = *((const f32x4*)g + lane + 64 * j);
    f32x4 nv[4], nu[4];
    { const f32x4* xr = (const f32x4*)(x + (size_t)gw * DM) + lane; const f32x4* xq = (const f32x4*)(x + (size_t)(gw + nw) * DM) + lane;
#pragma unroll
      for (int j = 0; j < 4; ++j) { nv[j] = xr[64 * j]; nu[j] = xq[64 * j]; } }
#pragma unroll 1
    for (int r = gw; r < TG; r += 2 * nw) { const int r2 = r + nw; f32x4 v[4], u[4]; float s = 0.f, s2 = 0.f;
#pragma unroll
        for (int j = 0; j < 4; ++j) { v[j] = nv[j]; u[j] = nu[j]; }
        if (r + 2 * nw < TG) { const f32x4* yr = (const f32x4*)(x + (size_t)(r + 2 * nw) * DM) + lane; const f32x4* yq = (const f32x4*)(x + (size_t)(r2 + 2 * nw) * DM) + lane;
#pragma unroll
            for (int j = 0; j < 4; ++j) { nv[j] = yr[64 * j]; nu[j] = yq[64 * j]; } }
        f32x4* xr = (f32x4*)(x + (size_t)r * DM) + lane; f32x4* xq = (f32x4*)(x + (size_t)r2 * DM) + lane;
#pragma unroll
        for (int j = 0; j < 4; ++j) { s += (v[j].x * v[j].x + v[j].y * v[j].y) + (v[j].z * v[j].z + v[j].w * v[j].w); s2 += (u[j].x * u[j].x + u[j].y * u[j].y) + (u[j].z * u[j].z + u[j].w * u[j].w); }
        const float rstd = __builtin_amdgcn_rsqf(wave_sum(s) * (1.0f / DM) + 1e-6f), rstd2 = __builtin_amdgcn_rsqf(wave_sum(s2) * (1.0f / DM) + 1e-6f);
#pragma unroll
        for (int j = 0; j < 4; ++j) { xr[64 * j] = v[j] * rstd * gv[j]; xq[64 * j] = u[j] * rstd2 * gv[j]; } }
}
__device__ __forceinline__ void shift8(u32x4 cw, u32x4 pw, u32x4 nw, const float* m0, const float* m1, float* out) {
    float c[8], pv[8], nx[8]; unpack8(cw, c); unpack8(pw, pv); unpack8(nw, nx);
#pragma unroll
    for (int i = 0; i < 8; ++i) out[i] = c[i] + m0[i] * (pv[i] - c[i]) + m1[i] * (nx[i] - c[i]);
}
__device__ __forceinline__ f16x8 tof16x8(const float* v) { f16x8 o;
#pragma unroll
    for (int i = 0; i < 8; ++i) o[i] = (f16)v[i];
    return o; }
struct PrepRaw { u32x4 cr, pr, nr, ck, pk, nk, cv, pv, nv, cb, pb, nb, cm; };
__device__ __forceinline__ PrepRaw prep_load(const bf16_t* P2, int tok, int lane, int colB) {
    const int t = tok & (SEQ - 1); const bool hp = t > 0, hn = t < SEQ - 1; const bf16_t* row = P2 + (size_t)tok * NP2;
    const bf16_t* rp = hp ? row - NP2 : row; const bf16_t* rn = hn ? row + NP2 : row; const u32x4 z4 = {0, 0, 0, 0}; PrepRaw x;
    x.cr = *(const u32x4*)(row + 8 * lane); x.pr = *(const u32x4*)(rp + 8 * lane); x.nr = *(const u32x4*)(rn + 8 * lane);
    x.ck = *(const u32x4*)(row + 512 + 8 * lane); x.pk = *(const u32x4*)(rp + 512 + 8 * lane); x.nk = *(const u32x4*)(rn + 512 + 8 * lane);
    x.cv = *(const u32x4*)(row + 1024 + 8 * lane); x.pv = *(const u32x4*)(rp + 1024 + 8 * lane); x.nv = *(const u32x4*)(rn + 1024 + 8 * lane);
    x.cb = *(const u32x4*)(row + colB); x.pb = *(const u32x4*)(rp + colB); x.nb = *(const u32x4*)(rn + colB);
    x.cm = *(const u32x4*)(row + 1952 + 8 * (lane < 52 ? lane : 0));
    if (!hp) { x.pr = z4; x.pk = z4; x.pv = z4; x.pb = z4; }
    if (!hn) { x.nr = z4; x.nk = z4; x.nv = z4; x.nb = z4; }
    return x;
}
__device__ __forceinline__ void phase_prep(CParams& P, int l) {
    const int tid = tid_(), lane = tid & 63, gw = bid_() * NWAVES + (tid >> 6), nw = nblk_() * NWAVES;
    const bf16_t* P2 = (const bf16_t*)(P.ws + WS_P2); f16* SC = (f16*)(P.ws + WS_SC); f16* V16 = (f16*)(P.ws + WS_V16); bf16_t* LIN = (bf16_t*)(P.ws + WS_LIN);
    float* rq = (float*)(P.ws + WS_RSTD); float* rkv = rq + TG; float* bs = (float*)(P.ws + WS_BS); bf16_t* KF = (bf16_t*)(P.ws + WS_KF);
    const float* cs = (const float*)(P.ws + WS_ROPE); const float* sn = cs + SEQ * 16;
    const float* mu = P.in[4] + (size_t)l * 2 * 1952; const float* kkw = P.in[10] + l * 512 + 8 * lane; const float* rkw = P.in[12] + l * 512 + 8 * lane;
    const int colB = 1536 + 8 * (lane < 52 ? lane : 0);
    float mr0[8], mr1[8], mk0[8], mk1[8], mv0[8], mv1[8], mb0[8], mb1[8], kkv[8], rkv8[8];
#pragma unroll
    for (int i = 0; i < 8; ++i) { mr0[i] = mu[8 * lane + i]; mr1[i] = mu[1952 + 8 * lane + i]; mk0[i] = mu[512 + 8 * lane + i]; mk1[i] = mu[1952 + 512 + 8 * lane + i];
        mv0[i] = mu[1024 + 8 * lane + i]; mv1[i] = mu[1952 + 1024 + 8 * lane + i]; mb0[i] = mu[colB + i]; mb1[i] = mu[1952 + colB + i]; kkv[i] = kkw[i]; rkv8[i] = rkw[i]; }
    PrepRaw nxt = prep_load(P2, gw, lane, colB);
#pragma unroll 1
    for (int tok = gw; tok < TG; tok += nw) { const int t = tok & (SEQ - 1); const PrepRaw x = nxt;
        if (tok + nw < TG) nxt = prep_load(P2, tok + nw, lane, colB);
        float csv[8], snv[8];
        { const int j0 = (lane & 1) * 8;
#pragma unroll
          for (int i = 0; i < 8; ++i) { csv[i] = cs[t * 16 + j0 + i]; snv[i] = sn[t * 16 + j0 + i]; } }
        { float r8[8], k8[8], v8[8], kk8[8]; shift8(x.cr, x.pr, x.nr, mr0, mr1, r8); shift8(x.ck, x.pk, x.nk, mk0, mk1, k8); shift8(x.cv, x.pv, x.nv, mv0, mv1, v8);
          float ss = 0.f, bsum = 0.f;
#pragma unroll
          for (int i = 0; i < 8; ++i) { kk8[i] = k8[i] * kkv[i]; ss += kk8[i] * kk8[i]; bsum += r8[i] * k8[i] * rkv8[i]; }
          ss = sum8(ss); bsum = sum8(bsum); const float inv = __builtin_amdgcn_rsqf(fmaxf(ss, 1e-24f));
#pragma unroll
          for (int i = 0; i < 8; ++i) kk8[i] *= inv;
          const int head = lane >> 3, d0 = (lane & 7) * 8; const f16x8 rh = tof16x8(r8), kh = tof16x8(k8), kkh = tof16x8(kk8);
          { f16* p = SC + ((size_t)tok * 8 + head) * 192 + d0; *(f16x8*)(p) = rh; *(f16x8*)(p + 64) = kh; *(f16x8*)(p + 128) = kkh; }
          *(f16x8*)(V16 + (size_t)tok * 512 + 8 * lane) = tof16x8(v8);
          if ((lane & 7) == 0) bs[tok * 8 + head] = bsum; }
        { float o[8];
          if (lane < 52) { shift8(x.cb, x.pb, x.nb, mb0, mb1, o);
              if (lane < 16) {
#pragma unroll
                  for (int i = 0; i < 8; ++i) o[i] = 2.0f * sigmoidf_(2.0f * o[i]) - 1.0f; }
              else if (lane >= 32) {
#pragma unroll
                  for (int i = 0; i < 8; ++i) o[i] = sigmoidf_(o[i]); } }
          else {
#pragma unroll
              for (int i = 0; i < 8; ++i) o[i] = 0.f; }
          *(u32x4*)(LIN + (size_t)tok * 512 + 8 * lane) = pack8(o); }
        { float xv[8]; float ss = 0.f; unpack8(x.cm, xv);
          if (lane < 52) {
#pragma unroll
              for (int i = 0; i < 8; ++i) ss += xv[i] * xv[i]; }
          const float rs16 = red16(ss);
          const int rsi = __builtin_bit_cast(int, rs16); const float sq = __builtin_bit_cast(float, __builtin_amdgcn_readlane(rsi, 0)) + __builtin_bit_cast(float, __builtin_amdgcn_readlane(rsi, 16)), skv = __builtin_bit_cast(float, __builtin_amdgcn_readlane(rsi, 32));
          if (lane == 0) { rq[tok] = __builtin_amdgcn_rsqf(sq * (1.0f / 256.0f) + 1e-6f); rkv[tok] = __builtin_amdgcn_rsqf(skv * (1.0f / 128.0f) + 1e-6f); }
          float y[8];
#pragma unroll
          for (int i = 0; i < 8; ++i) y[i] = DPP_F(xv[i], 0x4E);
          if (lane >= 48 && lane < 52) { const int half = (lane - 48) >> 1; float o[8];
#pragma unroll
              for (int i = 0; i < 8; ++i) o[i] = half ? (xv[i] * csv[i] + y[i] * snv[i]) : (xv[i] * csv[i] - y[i] * snv[i]);
              const u32x4 w = pack8(o);
#pragma unroll
              for (int h = 0; h < 8; ++h) *(u32x4*)(KF + (size_t)tok * 768 + h * 96 + 64 + (lane - 48) * 8) = w; } }
    }
}
__device__ __forceinline__ void phase_post(CParams& P, int l) {
    const int tid = tid_(), lane = tid & 63, gw = bid_() * NWAVES + (tid >> 6), nw = nblk_() * NWAVES;
    const float* OF = (const float*)(P.ws + WS_P2); const float* OB = OF + (size_t)TG * 512; const f16* V16 = (const f16*)(P.ws + WS_V16);
    const bf16_t* G = (const bf16_t*)(P.ws + WS_G); bf16_t* YA = (bf16_t*)(P.ws + WS_LIN); const float* bs = (const float*)(P.ws + WS_BS);
    const float* gg = P.in[13] + l * 512 + 8 * lane; const float* gb = P.in[14] + l * 512 + 8 * lane;
    float ggv[8], gbv[8];
#pragma unroll
    for (int i = 0; i < 8; ++i) { ggv[i] = gg[i]; gbv[i] = gb[i]; }
    constexpr int PT = 4;
#pragma unroll 1
    for (int tok = gw; tok < TG; tok += PT * nw) {
        f32x4 a0[PT], a1[PT], b0[PT], b1[PT]; f16x8 v[PT]; u32x4 gq[PT]; float bon[PT], o[PT][8];
#pragma unroll
        for (int k = 0; k < PT; ++k) { const size_t off = (size_t)(tok + k * nw) * 512 + 8 * lane;
            a0[k] = *(const f32x4*)(OF + off); a1[k] = *(const f32x4*)(OF + off + 4); b0[k] = *(const f32x4*)(OB + off); b1[k] = *(const f32x4*)(OB + off + 4);
            v[k] = *(const f16x8*)(V16 + off); gq[k] = *(const u32x4*)(G + off); bon[k] = bs[(tok + k * nw) * 8 + (lane >> 3)]; }
#pragma unroll
        for (int k = 0; k < PT; ++k) { float s = 0.f;
#pragma unroll
            for (int i = 0; i < 4; ++i) { o[k][i] = a0[k][i] + b0[k][i]; o[k][4 + i] = a1[k][i] + b1[k][i]; }
#pragma unroll
            for (int i = 0; i < 8; ++i) s += o[k][i];
            const float mean = sum8(s) * (1.0f / 64.0f); float q = 0.f;
#pragma unroll
            for (int i = 0; i < 8; ++i) { o[k][i] -= mean; q += o[k][i] * o[k][i]; }
            const float rstd = __builtin_amdgcn_rsqf(sum8(q) * (1.0f / 64.0f) + 64e-5f); float g[8]; unpack8(gq[k], g);
#pragma unroll
            for (int i = 0; i < 8; ++i) o[k][i] = (o[k][i] * rstd * ggv[i] + gbv[i] + bon[k] * (float)v[k][i]) * g[i];
            *(u32x4*)(YA + (size_t)(tok + k * nw) * 512 + 8 * lane) = pack8(o[k]); } }
}
#define MFMA32(a, b, c) __builtin_amdgcn_mfma_f32_32x32x16_bf16((a), (b), (c), 0, 0, 0)
#define AT_BAR() do { asm volatile("s_waitcnt lgkmcnt(0)" ::: "memory"); __builtin_amdgcn_s_barrier(); asm volatile("" ::: "memory"); } while (0)
__device__ __forceinline__ void phase_attn(CParams& P, LAS unsigned char* lds) {
    const int tid = tid_(), lane = tid & 63, wid = tid >> 6, ql = lane & 31, hi = lane >> 5;
    const bf16_t* Q = (const bf16_t*)(P.ws + WS_Q); const bf16_t* KF = (const bf16_t*)(P.ws + WS_KF); const bf16_t* VT = (const bf16_t*)(P.ws + WS_VT); bf16_t* O = (bf16_t*)(P.ws + WS_OATT);
    const int G = nblk_(), bx = bid_(); const int vcu = (G % 8 == 0) ? (bx % 8) * (G / 8) + bx / 8 : bx;
    constexpr int KROW = 208, VROW = 272, KBUF = 128 * KROW, VBUF = 64 * VROW, VOFF = 2 * KBUF, NT = SEQ / 128;
    static_assert(VOFF + 2 * VBUF <= 131072, "attention LDS map");
    const int kr0 = tid / 12, kc0 = tid % 12, kr1 = (512 + tid) / 12, kc1 = (512 + tid) % 12, kr2 = (1024 + tid) / 12, kc2 = (1024 + tid) % 12, vr0 = tid >> 4, vc0 = tid & 15, vr1 = 32 + vr0, vgo = (vc0 >> 1) * 32 + (vc0 & 1) * 8;
#define AT_GLOAD(kt) do { ka = *(const u32x4*)(kg0 + (size_t)(kt) * 128 * 768); kb = *(const u32x4*)(kg1 + (size_t)(kt) * 128 * 768); kc = *(const u32x4*)(kg2 + (size_t)(kt) * 128 * 768); \
        va = *(const u32x4*)(vg0 + (kt) * 128); vb = *(const u32x4*)(vg1 + (kt) * 128); } while (0)
#define AT_LWRITE(nb) do { LAS unsigned char* kq = lds + (nb) * KBUF; LAS unsigned char* vq = lds + VOFF + (nb) * VBUF; \
        *(LAS u32x4*)(kq + kr0 * KROW + kc0 * 16) = ka; *(LAS u32x4*)(kq + kr1 * KROW + kc1 * 16) = kb; *(LAS u32x4*)(kq + kr2 * KROW + kc2 * 16) = kc; \
        *(LAS u32x2*)(vq + vr0 * VROW + vgo) = (u32x2){va.x, va.y}; *(LAS u32x2*)(vq + vr0 * VROW + vgo + 16) = (u32x2){va.z, va.w}; \
        *(LAS u32x2*)(vq + vr1 * VROW + vgo) = (u32x2){vb.x, vb.y}; *(LAS u32x2*)(vq + vr1 * VROW + vgo + 16) = (u32x2){vb.z, vb.w}; } while (0)
#define AT_KFRAG(buf, sub) do { const LAS unsigned char* kb_ = lds + (buf) * KBUF + ((sub) * 64 + ql) * KROW + hi * 16; _Pragma("unroll") for (int ds = 0; ds < 6; ++ds) { \
        kfa[ds] = *(const LAS bf16x8*)(kb_ + ds * 32); kfb[ds] = *(const LAS bf16x8*)(kb_ + 32 * KROW + ds * 32); } } while (0)
#define AT_QK(S) do { const f32x16 zz = {}; S##0 = MFMA32(kfa[0], qf[0], zz); S##1 = MFMA32(kfb[0], qf[0], zz); _Pragma("unroll") for (int ds = 1; ds < 6; ++ds) { \
        S##0 = MFMA32(kfa[ds], qf[ds], S##0); S##1 = MFMA32(kfb[ds], qf[ds], S##1); } } while (0)
#define AT_VFRAG(buf, sub) do { const LAS unsigned char* vb_ = lds + VOFF + (buf) * VBUF + ql * VROW + (sub) * 128 + hi * 16; _Pragma("unroll") for (int ks = 0; ks < 4; ++ks) { \
        vfa[ks] = *(const LAS bf16x8*)(vb_ + ks * 32); vfb[ks] = *(const LAS bf16x8*)(vb_ + 32 * VROW + ks * 32); } } while (0)
#define AT_PV() do { _Pragma("unroll") for (int ks = 0; ks < 4; ++ks) { o0 = MFMA32(vfa[ks], pf[ks], o0); o1 = MFMA32(vfb[ks], pf[ks], o1); } } while (0)
#define AT_SM(S, N, FIXN, first) do { \
        float mxa = __builtin_fmaxf(__builtin_fmaxf(S##0[0], S##0[1]), S##1[0]), mxb = __builtin_fmaxf(__builtin_fmaxf(S##0[2], S##0[3]), S##1[1]); mxa = __builtin_fmaxf(__builtin_fmaxf(mxa, S##1[2]), S##1[3]); \
        _Pragma("unroll") for (int r = 4; r < 16; r += 4) { mxa = __builtin_fmaxf(__builtin_fmaxf(mxa, S##0[r]), S##0[r + 1]); mxb = __builtin_fmaxf(__builtin_fmaxf(mxb, S##0[r + 2]), S##0[r + 3]); \
            mxa = __builtin_fmaxf(__builtin_fmaxf(mxa, S##1[r]), S##1[r + 1]); mxb = __builtin_fmaxf(__builtin_fmaxf(mxb, S##1[r + 2]), S##1[r + 3]); } \
        float mx = __builtin_fmaxf(mxa, mxb); { const auto rr_ = __builtin_amdgcn_permlane32_swap(__float_as_uint(mx), __float_as_uint(mx), false, false); mx = __builtin_fmaxf(__uint_as_float(rr_[0]), __uint_as_float(rr_[1])); } const float rel = mx - mrun; \
        if (__any(rel > 8.0f || ((first) && rel < -8.0f))) { const float dl = (first) ? ((rel > 8.0f || rel < -8.0f) ? rel : 0.f) : fmaxf(rel, 0.f); const float alpha = (first) ? 0.f : __builtin_amdgcn_exp2f(-dl); mrun += dl; lrun *= alpha; \
            _Pragma("unroll") for (int r = 0; r < 16; ++r) { o0[r] *= alpha; o1[r] *= alpha; } } \
        if (__any(mrun != 0.f)) { _Pragma("unroll") for (int r = 0; r < 16; ++r) { S##0[r] -= mrun; S##1[r] -= mrun; } } \
        _Pragma("unroll") for (int r = 0; r < 16; ++r) { S##0[r] = __builtin_amdgcn_exp2f(S##0[r]); S##1[r] = __builtin_amdgcn_exp2f(S##1[r]); } \
        { f32x2 pa = (f32x2){S##0[0], S##0[1]} + (f32x2){S##0[2], S##0[3]}, pb = (f32x2){S##1[0], S##1[1]} + (f32x2){S##1[2], S##1[3]}; \
          _Pragma("unroll") for (int r = 4; r < 16; r += 4) { pa += (f32x2){S##0[r], S##0[r + 1]}; pb += (f32x2){S##1[r], S##1[r + 1]}; pa += (f32x2){S##0[r + 2], S##0[r + 3]}; pb += (f32x2){S##1[r + 2], S##1[r + 3]}; } \
          pa += pb; lrun += pa[0] + pa[1]; } \
        _Pragma("unroll") for (int j = 0; j < 2; ++j) { u32x4 w0, w1; \
            w0.x = cvtpk(S##0[8 * j], S##0[8 * j + 1]); w0.y = cvtpk(S##0[8 * j + 2], S##0[8 * j + 3]); w0.z = cvtpk(S##0[8 * j + 4], S##0[8 * j + 5]); w0.w = cvtpk(S##0[8 * j + 6], S##0[8 * j + 7]); \
            w1.x = cvtpk(S##1[8 * j], S##1[8 * j + 1]); w1.y = cvtpk(S##1[8 * j + 2], S##1[8 * j + 3]); w1.z = cvtpk(S##1[8 * j + 4], S##1[8 * j + 5]); w1.w = cvtpk(S##1[8 * j + 6], S##1[8 * j + 7]); \
            pf[j] = __builtin_bit_cast(bf16x8, w0); pf[2 + j] = __builtin_bit_cast(bf16x8, w1); } } while (0)
    for (int u = vcu; u < GSEQ * 8 * 16; u += G) {
        const int sh = u >> 4, qb = u & 15, s = sh >> 3, h = sh & 7; const size_t tok0 = (size_t)s * SEQ;
        bf16x8 qf[6]; { const bf16_t* qp = Q + (tok0 + qb * 256 + wid * 32 + ql) * 768 + h * 96 + 8 * hi;
#pragma unroll
            for (int ds = 0; ds < 6; ++ds) qf[ds] = *(const bf16x8*)(qp + 16 * ds); }
        const bf16_t* kg0 = KF + (tok0 + kr0) * 768 + h * 96 + kc0 * 8; const bf16_t* kg1 = KF + (tok0 + kr1) * 768 + h * 96 + kc1 * 8; const bf16_t* kg2 = KF + (tok0 + kr2) * 768 + h * 96 + kc2 * 8;
        const bf16_t* vg0 = VT + ((size_t)(s * 8 + h) * 64 + vr0) * SEQ + vc0 * 8; const bf16_t* vg1 = vg0 + (size_t)32 * SEQ;
        u32x4 ka, kb, kc, va, vb;
        f32x16 o0 = {}, o1 = {}, pA0, pA1; float mrun = 0.f, lrun = 0.f; bf16x8 pf[4], kfa[6], kfb[6], vfa[4], vfb[4];
        AT_GLOAD(0); AT_LWRITE(0);
        AT_BAR();
#pragma unroll 1
        for (int kt = 0; kt < NT; ++kt) { const int cur = kt & 1;
            if (kt + 1 < NT) AT_GLOAD(kt + 1);
            AT_KFRAG(cur, 0);
            AT_QK(pA); AT_VFRAG(cur, 0); AT_SM(pA, pA, false, kt == 0); AT_KFRAG(cur, 1); AT_PV();
            AT_QK(pA); AT_VFRAG(cur, 1); AT_SM(pA, pA, false, false); AT_PV();
            if (kt + 1 < NT) AT_LWRITE(cur ^ 1);
            AT_BAR(); }
        { const auto rr_ = __builtin_amdgcn_permlane32_swap(__float_as_uint(lrun), __float_as_uint(lrun), false, false); lrun = __uint_as_float(rr_[0]) + __uint_as_float(rr_[1]); } const float inv = 1.0f / lrun;
        bf16_t* op = O + (tok0 + qb * 256 + wid * 32 + ql) * 512 + h * 64 + 4 * hi;
#pragma unroll
        for (int g = 0; g < 4; ++g) { u32x2 w0, w1; w0.x = cvtpk(o0[4 * g] * inv, o0[4 * g + 1] * inv); w0.y = cvtpk(o0[4 * g + 2] * inv, o0[4 * g + 3] * inv);
            w1.x = cvtpk(o1[4 * g] * inv, o1[4 * g + 1] * inv); w1.y = cvtpk(o1[4 * g + 2] * inv, o1[4 * g + 3] * inv);
            *(u32x2*)(op + 8 * g) = w0; *(u32x2*)(op + 32 + 8 * g) = w1; }
    }
    __syncthreads();
#undef AT_GLOAD
#undef AT_LWRITE
#undef AT_KFRAG
#undef AT_QK
#undef AT_VFRAG
#undef AT_PV
#undef AT_SM
}
__device__ __forceinline__ void phase_scan(CParams& P, LAS unsigned char* lds) {
    const int tid = tid_(), lane = tid & 63, wid = tid >> 6; const int nb_ = nblk_();
    const f16* SC = (const f16*)(P.ws + WS_SC); const f16* SCD = (const f16*)(P.ws + WS_SCD); const f16* V16 = (const f16*)(P.ws + WS_V16);
    constexpr int STEPF = 352, CH = 32, NCH = SEQ / CH, BUFF = CH * STEPF;
    LAS float* lf = (LAS float*)lds;
    const int bx_ = bid_(); const int vcu_ = (nb_ % 8 == 0) ? (bx_ % 8) * (nb_ / 8) + bx_ / 8 : bx_;
    for (int task = vcu_; task < GSEQ * 8 * 2 * 2; task += nb_) {
        const int rowhalf = task & 1, dir = (task >> 1) & 1, h = (task >> 2) & 7, s = task >> 5;
        float* OUT = (float*)(P.ws + WS_P2) + (size_t)dir * TG * 512;
        __syncthreads();
        if (wid >= 4) {
            const int ltid = tid - 256; f16x8 v[6];
#define SC_GLOAD(cn) do { _Pragma("unroll") for (int i = 0; i < 6; ++i) { const int p = ltid + 256 * i; if (p < CH * 44) { const int j = p / 44, q = p - j * 44; const int st = (cn) * CH + j; const int t = dir ? (SEQ - 1 - st) : st; const size_t tok = (size_t)s * SEQ + t; \
                const f16* ss_ = SC + (tok * 8 + h) * 192; const f16* sd_ = SCD + (((size_t)dir * TG + tok) * 8 + h) * 192; \
                const f16* src = q < 8 ? ss_ + q * 8 : q < 24 ? sd_ + (q - 8) * 8 : q < 32 ? ss_ + 128 + (q - 24) * 8 : q < 40 ? sd_ + 128 + (q - 32) * 8 : V16 + tok * 512 + h * 64 + rowhalf * 32 + (q - 40) * 8; v[i] = *(const f16x8*)src; } } } while (0)
#define SC_WRITE(cn) do { LAS float* dst = lf + ((cn) & 1) * BUFF; _Pragma("unroll") for (int i = 0; i < 6; ++i) { const int p = ltid + 256 * i; if (p < CH * 44) { const int j = p / 44, q = p - j * 44; LAS float* d = dst + j * STEPF + q * 8; \
                *(LAS f32x4*)d = (f32x4){(float)v[i][0], (float)v[i][1], (float)v[i][2], (float)v[i][3]}; *(LAS f32x4*)(d + 4) = (f32x4){(float)v[i][4], (float)v[i][5], (float)v[i][6], (float)v[i][7]}; } } } while (0)
            SC_GLOAD(0); SC_WRITE(0); SC_GLOAD(1);
#pragma unroll 1
            for (int c = 0; c < NCH; ++c) {
                __syncthreads();
                if (c + 1 < NCH) { SC_WRITE(c + 1); if (c + 2 < NCH) SC_GLOAD(c + 2); }
            }
            __syncthreads();
#undef SC_GLOAD
#undef SC_WRITE
        } else {
            const int rl = lane >> 3, oct = lane & 7, rloc = wid * 8 + rl;
            __builtin_amdgcn_s_setprio(3);
            f32x4 s0 = {0.f, 0.f, 0.f, 0.f}, s1 = {0.f, 0.f, 0.f, 0.f};
            float* op = OUT + ((size_t)s * SEQ + (dir ? SEQ - 1 : 0)) * 512 + h * 64 + rowhalf * 32 + rloc; const long ostep = dir ? -512 : 512;
#define SC_LOAD(X, sp) do { X##r0 = *(const LAS f32x4*)(sp); X##r1 = *(const LAS f32x4*)((sp) + 4); X##w0 = *(const LAS f32x4*)((sp) + 64); X##w1 = *(const LAS f32x4*)((sp) + 68); \
        X##k0 = *(const LAS f32x4*)((sp) + 128); X##k1 = *(const LAS f32x4*)((sp) + 132); X##q0 = *(const LAS f32x4*)((sp) + 192); X##q1 = *(const LAS f32x4*)((sp) + 196); \
        X##b0 = *(const LAS f32x4*)((sp) + 256); X##b1 = *(const LAS f32x4*)((sp) + 260); X##vv = (sp)[320 - 8 * oct + rloc]; } while (0)
#define SC_STEP(X) do { const f32x4 pp = s0 * X##q0 + s1 * X##q1; float sa = (pp[0] + pp[1]) + (pp[2] + pp[3]); \
        const f32x4 c0 = s0 * X##w0 + X##vv * X##k0, c1 = s1 * X##w1 + X##vv * X##k1; sa = red8(sa); \
        s0 = c0 + sa * X##b0; s1 = c1 + sa * X##b1; const f32x4 tt = s0 * X##r0 + s1 * X##r1; float o = (tt[0] + tt[1]) + (tt[2] + tt[3]); o = red8(o); *op = o; op += ostep; } while (0)
            f32x4 Ar0, Ar1, Aw0, Aw1, Ak0, Ak1, Aq0, Aq1, Ab0, Ab1, Br0, Br1, Bw0, Bw1, Bk0, Bk1, Bq0, Bq1, Bb0, Bb1; float Avv, Bvv;
#pragma unroll 1
            for (int c = 0; c < NCH; ++c) {
                __syncthreads();
                const LAS float* base = lf + (c & 1) * BUFF + 8 * oct;
                SC_LOAD(A, base);
#pragma unroll 2
                for (int j = 0; j < CH; j += 2) { const LAS float* sp = base + j * STEPF;
                    SC_LOAD(B, sp + STEPF); SC_STEP(A);
                    SC_LOAD(A, sp + 2 * STEPF);
                    SC_STEP(B); }
            }
#undef SC_LOAD
#undef SC_STEP
            __builtin_amdgcn_s_setprio(0);
            __syncthreads();
        }
    }
    __syncthreads();
}
enum { ST_NORM1 = 0, ST_IN, ST_PREP, ST_DECAY, ST_ICLR, ST_GATE, ST_Q, ST_KV, ST_ATTN, ST_SCAN, ST_POST, ST_OA, ST_OB, ST_OUT, ST_NORM2, ST_GU, ST_DOWN, ST_COUNT };
constexpr int PH_PER_LAYER = ST_COUNT, PH_PER_GROUP = DEPTH * PH_PER_LAYER + 1, N_PHASES = 1 + NGROUP * PH_PER_GROUP;
__host__ __device__ __forceinline__ bool phase_needs_sync(int ph) {
    if (ph == 0) return false;
    const int r = (ph - 1) % PH_PER_GROUP; if (r == DEPTH * PH_PER_LAYER) return true;
    const int st = r % PH_PER_LAYER;
    return !(st == ST_ICLR || st == ST_GATE || st == ST_Q || st == ST_KV || st == ST_SCAN || st == ST_OB);
}
template <class Epi> __device__ __forceinline__ void run_gemm(LAS unsigned char* lds, const bf16_t* A, int lda, const bf16_t* Bt, int N, int K, const Epi& E) {
    int ldb = K; asm volatile("" : "+s"(N), "+s"(K), "+s"(lda), "+s"(ldb));
    pg8::Gemm g{A, Bt, TG, N, K, lda, ldb}; pg8::StaticOrder S; S.init(TG, N, nblk_(), bid_());
    pg8::gemm_phase<Epi, pg8::StaticOrder, true, true>(lds, g, S, E);
}
__device__ __forceinline__ void run_phase(CParams& P, LAS unsigned char* lds, int ph) {
    if (ph == 0) { phase_weights(P); return; }
    const int pg = ph - 1, g = pg / PH_PER_GROUP, r = pg % PH_PER_GROUP;
    float* xo = P.out + (size_t)g * TG * DM;
    if (r == DEPTH * PH_PER_LAYER) { phase_final_norm(xo, P.in[25]); return; }
    const int l = r / PH_PER_LAYER, st = r % PH_PER_LAYER;
    const float* xin = (g < 2) ? P.in[0] + (size_t)g * TG * DM : P.in[1];
    const float* xsrc = (l == 0) ? xin : xo;
    unsigned char* ws = P.ws; const unsigned char* wb = ws + WS_W + (size_t)l * WL_SIZE;
    bf16_t* H = (bf16_t*)(ws + WS_H); bf16_t* P2 = (bf16_t*)(ws + WS_P2); bf16_t* GATES = (bf16_t*)(ws + WS_GATES); f16* SC = (f16*)(ws + WS_SC); f16* SCD = (f16*)(ws + WS_SCD);
    bf16_t* LIN = (bf16_t*)(ws + WS_LIN); const float* rq = (const float*)(ws + WS_RSTD); const float* cs = (const float*)(ws + WS_ROPE);
#ifdef ONLY_STEP
    if (st != ONLY_STEP) return;
#endif
    switch (st) {
    case ST_NORM1: phase_norm(xsrc, P.in[2] + l * DM, H); break;
    case ST_IN: { EpiIn E{GATES, P2}; run_gemm(lds, H, DM, (const bf16_t*)(wb + WL_IN), NINP, DM, E); } break;
    case ST_PREP: phase_prep(P, l); break;
    case ST_DECAY: { EpiDecay E{SCD, P.in[6] + l * 1024}; run_gemm(lds, LIN, 512, (const bf16_t*)(wb + WL_DEC), 1024, 128, E); } break;
    case ST_ICLR: { EpiIclr E{SC, SCD, P.in[8] + l * 1024, P.in[11] + l * 512}; run_gemm(lds, LIN + 128, 512, (const bf16_t*)(wb + WL_ICL), 1024, 128, E); } break;
    case ST_GATE: { EpiPlain E{(bf16_t*)(ws + WS_G), 512}; run_gemm(lds, LIN + 256, 512, (const bf16_t*)(wb + WL_GATE), 512, 256, E); } break;
    case ST_Q: { EpiQ E{(bf16_t*)(ws + WS_Q), rq, cs, cs + SEQ * 16}; run_gemm(lds, P2 + 1952, NP2, (const bf16_t*)(wb + WL_UQ), 768, 256, E); } break;
    case ST_KV: { EpiKV E{(bf16_t*)(ws + WS_KF), (bf16_t*)(ws + WS_VT), rq + TG}; run_gemm(lds, P2 + 2208, NP2, (const bf16_t*)(wb + WL_UKV), 1024, 128, E); } break;
    case ST_ATTN: phase_attn(P, lds); break;
    case ST_SCAN: phase_scan(P, lds); break;
    case ST_POST: phase_post(P, l); break;
    case ST_OA: { EpiMix<0> E{H, GATES}; run_gemm(lds, LIN, 512, (const bf16_t*)(wb + WL_OA), 1024, 512, E); } break;
    case ST_OB: { EpiMix<1> E{H, GATES}; run_gemm(lds, (const bf16_t*)(ws + WS_OATT), 512, (const bf16_t*)(wb + WL_OB), 1024, 512, E); } break;
    case ST_OUT: { EpiRes E{xsrc, xo}; run_gemm(lds, H, DM, (const bf16_t*)(wb + WL_OUT), 1024, 1024, E); } break;
    case ST_NORM2: phase_norm(xo, P.in[22] + l * DM, H); break;
    case ST_GU: { EpiGU E{P2}; run_gemm(lds, H, DM, (const bf16_t*)(wb + WL_GU), NGU, DM, E); } break;
    case ST_DOWN: { EpiRes E{xo, xo}; run_gemm(lds, P2, DFF, (const bf16_t*)(wb + WL_DOWN), 1024, DFF, E); } break;
    }
}
__global__ void __launch_bounds__(NTHR, 2) mk_fwd(Params Punused) {
    extern __shared__ __attribute__((aligned(16))) unsigned char lds_raw[];
    LAS unsigned char* lds = (LAS unsigned char*)lds_raw;
    CParams* Pk = (CParams*)__builtin_amdgcn_kernarg_segment_ptr();
    const int lo = Pk->ph_lo, hi = Pk->ph_hi;
#if !MULTI_LAUNCH
    volatile LAS unsigned* bst = (volatile LAS unsigned*)(lds + LDS_BYTES - 64);
    if (threadIdx.x < 2) bst[threadIdx.x] = 0u;
    __syncthreads();
    const XcdBarrier bar = xcd_barrier_post((unsigned*)(Pk->ws + WS_BAR), bst);
#endif
    int rep = 0;
#pragma unroll 1
    for (int ph = lo; ph < hi;) {
#if !MULTI_LAUNCH
        if (ph > lo && rep == 0 && phase_needs_sync(ph)) { if (ph == 1) cg::this_grid().sync(); else xcd_barrier(bar); }
        else if (ph > lo) __syncthreads();
#endif
        CParams* Pl = Pk; int phl = ph; asm volatile("" : "+s"(Pl), "+s"(phl));
        run_phase(*Pl, lds, phl);
#ifdef REP_ST
        { const int r = (ph - 1) % PH_PER_GROUP; if (ph > 0 && r < DEPTH * PH_PER_LAYER && ((REP_ST >> (r % PH_PER_LAYER)) & 1) && rep < REP_N) { ++rep; continue; } }
#endif
        rep = 0; ++ph;
    }
}

extern "C" void kernel_launch(void* const* d_in, const int* in_sizes, int n_in, void* d_out, int out_size, void* d_ws, size_t ws_size, hipStream_t stream) {
    static int grid = 0;
    if (grid == 0) {
        if (n_in != 26 || ws_size < WS_END || out_size != 24 * SEQ * DM) { fprintf(stderr, "kernel_launch: unexpected shapes (n_in %d, ws %zu, out %d)\n", n_in, ws_size, out_size); grid = -1; return; }
        int dev = 0, cus = 0, per_cu = 0;
        (void)hipGetDevice(&dev); (void)hipDeviceGetAttribute(&cus, hipDeviceAttributeMultiprocessorCount, dev);
        (void)hipFuncSetAttribute((const void*)mk_fwd, hipFuncAttributeMaxDynamicSharedMemorySize, LDS_BYTES);
        (void)hipOccupancyMaxActiveBlocksPerMultiprocessor(&per_cu, (const void*)mk_fwd, NTHR, LDS_BYTES);
        (void)hipGetLastError();
        grid = (per_cu >= 1 && cus == 256) ? cus : -1;
        if (grid < 0) { fprintf(stderr, "kernel_launch: occupancy query says %d blocks/CU\n", per_cu); return; }
    }
    if (grid < 0) return;
    if (hipMemsetAsync((char*)d_ws + WS_BAR, 0, XCD_BAR_WORDS * 4, stream) != hipSuccess) { fprintf(stderr, "kernel_launch: memset failed\n"); return; }
    Params p{};
    for (int i = 0; i < 26; ++i) p.in[i] = (const float*)d_in[i];
    p.out = (float*)d_out; p.ws = (unsigned char*)d_ws;
    for (int i = 0; i < 16; ++i) { const float e = (float)(2 * i) / 32.0f; const float pw = powf(10000.0f, e); p.invf[i] = 1.0f / pw; }
#if MULTI_LAUNCH
    for (int ph = 0; ph < N_PHASES; ++ph) { p.ph_lo = ph; p.ph_hi = ph + 1; hipLaunchKernelGGL(mk_fwd, dim3(grid), dim3(NTHR), LDS_BYTES, stream, p); }
#else
    p.ph_lo = 0; p.ph_hi = N_PHASES;
    void* args[] = {&p};
    hipError_t e = hipLaunchCooperativeKernel((const void*)mk_fwd, dim3(grid), dim3(NTHR), args, LDS_BYTES, stream);
    if (e != hipSuccess) fprintf(stderr, "cooperative launch failed: %s (grid %d)\n", hipGetErrorString(e), grid);
#endif
}
```
